# Optimizing an MI355X kernel written in HIP

```python
import math
import jax, jax.numpy as jnp
from jax import lax
import numpy as np

D_MODEL = 4096
BATCH = 4
SEQ = 4096
DEPTH = 1

CHUNK = 64
N_MEM = 256
SSM_WIDTH = D_MODEL // 2
CONV_WIDTH = D_MODEL - SSM_WIDTH
MIX_WIDTH = SSM_WIDTH + CONV_WIDTH
SSM_GROUP = 16
SSM_GROUPS = SSM_WIDTH // SSM_GROUP
SSM_STATE = 64
SHORT_CONV = 3
XATTN_HEADS = 4
XATTN_HEAD_DIM = D_MODEL // XATTN_HEADS
D_FF = ((8 * D_MODEL // 3 + 255) // 256) * 256
FFN_CONV = 3
EPS = 1e-6
DT_MIN = 1e-3
DT_MAX = 1e-1
PROJ_IN_WIDTH = SSM_WIDTH + 3 * CONV_WIDTH

kernel_name = "hymba_s5_shortconv_convffn_memxattn"


def rmsnorm(x, g):
    xf = x.astype(jnp.float32)
    y = xf * lax.rsqrt(jnp.mean(xf * xf, axis=-1, keepdims=True) + EPS)
    return (y * g.astype(jnp.float32)).astype(x.dtype)


def causal_dwconv(x, w):
    k_width = w.shape[0]
    length = x.shape[1]
    xp = jnp.pad(x, ((0, 0), (k_width - 1, 0), (0, 0)))
    y = xp[:, 0:length] * w[0]
    for k in range(1, k_width):
        y = y + xp[:, k:k + length] * w[k]
    return y


def _cmul(ar, ai, br, bi):
    return ar * br - ai * bi, ar * bi + ai * br


def _scan_combine(e1, e2):
    a1r, a1i, b1r, b1i = e1
    a2r, a2i, b2r, b2i = e2
    ar, ai = _cmul(a2r, a2i, a1r, a1i)
    br, bi = _cmul(a2r, a2i, b1r, b1i)
    return ar, ai, br + b2r, bi + b2i


def s5_mixer(u, lam_re, lam_im, log_step, b_re, b_im, c_re, c_im, d, glu_w, glu_b):
    f32 = jnp.float32
    bsz, length, _ = u.shape
    G, H, P, T = SSM_GROUPS, SSM_GROUP, SSM_STATE, CHUNK
    uf = u.astype(f32).reshape(bsz, length, G, H)
    lr = lam_re.astype(f32)
    li = lam_im.astype(f32)
    step = jnp.exp(log_step.astype(f32))[:, None]
    mag = jnp.exp(lr * step)
    ang = li * step
    abar_re, abar_im = mag * jnp.cos(ang), mag * jnp.sin(ang)
    den = lr * lr + li * li
    nr, ni = abar_re - 1.0, abar_im
    coef_re = (nr * lr + ni * li) / den
    coef_im = (ni * lr - nr * li) / den
    br_f, bi_f = b_re.astype(f32), b_im.astype(f32)
    bbar_re = coef_re[..., None] * br_f - coef_im[..., None] * bi_f
    bbar_im = coef_re[..., None] * bi_f + coef_im[..., None] * br_f
    cr_f, ci_f = c_re.astype(f32), c_im.astype(f32)
    kk = jnp.arange(1, T + 1, dtype=f32)[:, None, None]
    pmag = jnp.exp(lr * step * kk)
    pang = li * step * kk
    pow_re = (pmag * jnp.cos(pang))[:, None]
    pow_im = (pmag * jnp.sin(pang))[:, None]
    a_re = jnp.broadcast_to(abar_re, (T, 1, G, P))
    a_im = jnp.broadcast_to(abar_im, (T, 1, G, P))
    n_chunks = length // T
    uc = uf.reshape(bsz, n_chunks, T, G, H).transpose(1, 2, 0, 3, 4)

    def chunk_step(carry, u_c):
        sr, si = carry
        bu_re = jnp.einsum('tbgh,gph->tbgp', u_c, bbar_re)
        bu_im = jnp.einsum('tbgh,gph->tbgp', u_c, bbar_im)
        _, _, hr, hi = lax.associative_scan(_scan_combine, (a_re, a_im, bu_re, bu_im), axis=0)
        cr, ci = _cmul(pow_re, pow_im, sr[None], si[None])
        hr = hr + cr
        hi = hi + ci
        y = jnp.einsum('tbgp,ghp->tbgh', hr, cr_f) - jnp.einsum('tbgp,ghp->tbgh', hi, ci_f)
        return (hr[-1], hi[-1]), y

    init = (jnp.zeros((bsz, G, P), f32), jnp.zeros((bsz, G, P), f32))
    _, ys = lax.scan(chunk_step, init, uc)
    y = ys.transpose(2, 0, 1, 3, 4).reshape(bsz, length, G, H)
    y = y + d.astype(f32).reshape(G, H) * uf
    z = jax.nn.gelu(y.reshape(bsz, length, SSM_WIDTH)).astype(u.dtype)
    return z * jax.nn.sigmoid(z @ glu_w + glu_b)


def setup_inputs(seed: int = 0) -> dict:
    key = jax.random.key(seed)
    ks = jax.random.split(key, 32)
    f32 = jnp.float32
    nrm = lambda k, shape, scale: jax.random.normal(k, shape, f32) * scale
    gain = lambda k, n: 1.0 + 0.02 * jax.random.normal(k, (DEPTH, n), f32)
    G, H, P = SSM_GROUPS, SSM_GROUP, SSM_STATE
    lam_im_base = math.pi * jnp.arange(P, dtype=f32)
    return {
        "x": jax.random.normal(ks[0], (BATCH, SEQ, D_MODEL), f32),
        "mem": jax.random.normal(ks[1], (BATCH, N_MEM, D_MODEL), f32),
        "norm_mix_g": gain(ks[2], D_MODEL),
        "w_in": nrm(ks[3], (DEPTH, D_MODEL, PROJ_IN_WIDTH), D_MODEL ** -0.5),
        "ssm_lambda_re": -0.5 + 0.01 * jax.random.normal(ks[4], (DEPTH, G, P), f32),
        "ssm_lambda_im": lam_im_base + 0.01 * jax.random.normal(ks[5], (DEPTH, G, P), f32),
        "ssm_log_step": jax.random.uniform(ks[6], (DEPTH, G), f32, math.log(DT_MIN), math.log(DT_MAX)),
        "ssm_b_re": nrm(ks[7], (DEPTH, G, P, H), (2 * H) ** -0.5),
        "ssm_b_im": nrm(ks[8], (DEPTH, G, P, H), (2 * H) ** -0.5),
        "ssm_c_re": nrm(ks[9], (DEPTH, G, H, P), P ** -0.5),
        "ssm_c_im": nrm(ks[10], (DEPTH, G, H, P), P ** -0.5),
        "ssm_d": nrm(ks[11], (DEPTH, SSM_WIDTH), 1.0),
        "ssm_glu_w": nrm(ks[12], (DEPTH, SSM_WIDTH, SSM_WIDTH), SSM_WIDTH ** -0.5),
        "ssm_glu_b": nrm(ks[13], (DEPTH, SSM_WIDTH), 0.01),
        "conv_w": nrm(ks[14], (DEPTH, SHORT_CONV, CONV_WIDTH), SHORT_CONV ** -0.5),
        "out_norm_ssm_g": gain(ks[15], SSM_WIDTH),
        "out_norm_conv_g": gain(ks[16], CONV_WIDTH),
        "w_out": nrm(ks[17], (DEPTH, MIX_WIDTH, D_MODEL), MIX_WIDTH ** -0.5),
        "norm_xattn_g": gain(ks[18], D_MODEL),
        "norm_mem_g": gain(ks[19], D_MODEL),
        "xattn_wq": nrm(ks[20], (DEPTH, D_MODEL, D_MODEL), D_MODEL ** -0.5),
        "xattn_wk": nrm(ks[21], (DEPTH, D_MODEL, D_MODEL), D_MODEL ** -0.5),
        "xattn_wv": nrm(ks[22], (DEPTH, D_MODEL, D_MODEL), D_MODEL ** -0.5),
        "xattn_wo": nrm(ks[23], (DEPTH, D_MODEL, D_MODEL), D_MODEL ** -0.5),
        "norm_ffn_g": gain(ks[24], D_MODEL),
        "ffn_w_up": nrm(ks[25], (DEPTH, D_MODEL, 2 * D_FF), D_MODEL ** -0.5),
        "ffn_conv_w": nrm(ks[26], (DEPTH, FFN_CONV, D_FF), FFN_CONV ** -0.5),
        "ffn_conv_b": nrm(ks[27], (DEPTH, D_FF), 0.01),
        "ffn_w_down": nrm(ks[28], (DEPTH, D_FF, D_MODEL), D_FF ** -0.5),
        "norm_final_g": 1.0 + 0.02 * jax.random.normal(ks[29], (D_MODEL,), f32),
    }


def reference(x, mem, norm_mix_g, w_in, ssm_lambda_re, ssm_lambda_im, ssm_log_step,
              ssm_b_re, ssm_b_im, ssm_c_re, ssm_c_im, ssm_d, ssm_glu_w, ssm_glu_b,
              conv_w, out_norm_ssm_g, out_norm_conv_g, w_out,
              norm_xattn_g, norm_mem_g, xattn_wq, xattn_wk, xattn_wv, xattn_wo,
              norm_ffn_g, ffn_w_up, ffn_conv_w, ffn_conv_b, ffn_w_down, norm_final_g):
    bsz, length, _ = x.shape
    n_mem = mem.shape[1]
    split_pts = [SSM_WIDTH, SSM_WIDTH + CONV_WIDTH, SSM_WIDTH + 2 * CONV_WIDTH]
    for l in range(DEPTH):
        h = rmsnorm(x, norm_mix_g[l])
        proj = h @ w_in[l]
        u_ssm, gate_b, gate_c, v = jnp.split(proj, split_pts, axis=-1)
        y_ssm = s5_mixer(u_ssm, ssm_lambda_re[l], ssm_lambda_im[l], ssm_log_step[l],
                         ssm_b_re[l], ssm_b_im[l], ssm_c_re[l], ssm_c_im[l], ssm_d[l],
                         ssm_glu_w[l], ssm_glu_b[l])
        y_conv = gate_b * causal_dwconv(gate_c * v, conv_w[l])
        mixed = jnp.concatenate([rmsnorm(y_ssm, out_norm_ssm_g[l]),
                                 rmsnorm(y_conv, out_norm_conv_g[l])], axis=-1)
        x = x + mixed @ w_out[l]
        hq = rmsnorm(x, norm_xattn_g[l])
        hm = rmsnorm(mem, norm_mem_g[l])
        q = (hq @ xattn_wq[l]).reshape(bsz, length, XATTN_HEADS, XATTN_HEAD_DIM)
        k = (hm @ xattn_wk[l]).reshape(bsz, n_mem, XATTN_HEADS, XATTN_HEAD_DIM)
        vv = (hm @ xattn_wv[l]).reshape(bsz, n_mem, XATTN_HEADS, XATTN_HEAD_DIM)
        s = jnp.einsum('bqhd,bkhd->bhqk', q, k).astype(jnp.float32) * (XATTN_HEAD_DIM ** -0.5)
        p = jax.nn.softmax(s, axis=-1).astype(x.dtype)
        o = jnp.einsum('bhqk,bkhd->bqhd', p, vv).reshape(bsz, length, D_MODEL)
        x = x + o @ xattn_wo[l]
        h = rmsnorm(x, norm_ffn_g[l])
        up = h @ ffn_w_up[l]
        a, g = jnp.split(up, [D_FF], axis=-1)
        a = causal_dwconv(a, ffn_conv_w[l]) + ffn_conv_b[l]
        x = x + (jax.nn.silu(a) * g) @ ffn_w_down[l]
    return rmsnorm(x, norm_final_g)
```

```cpp
#include <hip/hip_runtime.h>
#include <cstdio>
#include <cstdint>

#define GAS __attribute__((address_space(1)))
#define LAS __attribute__((address_space(3)))
typedef unsigned short bf16;
typedef short bf16x8 __attribute__((ext_vector_type(8)));
typedef float f32x4 __attribute__((ext_vector_type(4)));
typedef float f32x2 __attribute__((ext_vector_type(2)));
typedef unsigned u32x4 __attribute__((ext_vector_type(4)));
typedef unsigned u32x2 __attribute__((ext_vector_type(2)));
typedef int i32x4 __attribute__((ext_vector_type(4)));
typedef int i32x8 __attribute__((ext_vector_type(8)));

constexpr int D = 4096, BATCH = 4, SEQ = 4096, M = BATCH * SEQ, NMEM = 256, MROWS = BATCH * NMEM;
constexpr int SSMW = 2048, CONVW = 2048, NG = 128, GH = 16, NP = 64, DFF = 11008, PROJW = 8192, NH = 4, HD = 1024, CW3 = 4096;
constexpr int TCH = 64, NCH = SEQ / TCH;
constexpr int UROW = 1152;
constexpr int LROW = 127 * 16;
constexpr float EPS = 1e-6f;
constexpr int NWAVES = 8, NTHR = 512;

constexpr size_t MiB = 1u << 20;
constexpr size_t WS_CTL = 0, CTL_ZERO_BYTES = 1 * MiB;
constexpr size_t CTL_ROWSS = 256 * 1024;
constexpr size_t CTL_XRMS = 832 * 1024;
constexpr size_t CTL_COLMAX = 640 * 1024;
constexpr size_t WS_WIN = 2 * MiB;
constexpr size_t WS_GLU = WS_WIN + 64 * MiB;
constexpr size_t WS_WOUT = WS_GLU + 8 * MiB;
constexpr size_t WS_WQ = WS_WOUT + 32 * MiB, WS_WK = WS_WQ + 32 * MiB, WS_WV = WS_WK + 32 * MiB, WS_WO = WS_WV + 32 * MiB;
constexpr size_t WS_WUP = WS_WO + 32 * MiB;
constexpr size_t WS_WDN = WS_WUP + 172 * MiB;
constexpr size_t WS_XB = WS_WDN + 86 * MiB;
constexpr size_t WS_HM = WS_XB + 128 * MiB;
constexpr size_t WS_KB = WS_HM + 8 * MiB;
constexpr size_t WS_VB = WS_KB + 8 * MiB;
constexpr size_t WS_A64 = WS_VB + 8 * MiB;
constexpr size_t WS_R = WS_A64 + 1 * MiB;
constexpr size_t WS_ACT = WS_R;
constexpr size_t WS_HALO = WS_ACT + 344 * MiB;
constexpr size_t WS_UG = WS_R;
constexpr size_t WS_PC = WS_UG + 72 * MiB;
constexpr size_t WS_Z8 = WS_PC + 64 * MiB;
constexpr size_t WS_SCB = WS_A64 + 512 * 1024;
constexpr size_t WS_A8 = WS_R + 520 * MiB;
constexpr float QCLIP = 4.2f, QCLIPW = 4.0f;
constexpr size_t WS_X8 = WS_UG;
constexpr size_t WS_WKB = WS_PC;
constexpr size_t WS_VWT = WS_PC + 32 * MiB;
constexpr size_t WS_Z = WS_PC + 192 * MiB;
constexpr size_t WS_MIX = WS_Z + 64 * MiB;
constexpr size_t WS_P = WS_MIX + 128 * MiB;
constexpr size_t WS_LT = WS_P + 32 * MiB;
constexpr size_t WS_EG = WS_LT + 8 * MiB;
constexpr size_t WS_FG = WS_EG + 32 * MiB;
constexpr size_t WS_SLOC = WS_FG + 32 * MiB;
constexpr size_t WS_END = WS_R + 688 * MiB;
static_assert(WS_HALO + 17 * MiB <= WS_A8 && WS_A8 + 64 * MiB <= WS_END, "halo / a8 fit");
static_assert(WS_SLOC + 16 * MiB <= WS_END, "overlay fits");
constexpr int CW_BAR = 4096;

constexpr int EX_OFF = 135168;
constexpr int RING_BYTES = 131072, TP_TILE = 64 * 65 * 4  , LDSCTL_OFF = 8 * TP_TILE, MISC_OFF = LDSCTL_OFF + 320, LDS_BYTES = 147456;
static_assert(LDSCTL_OFF >= RING_BYTES && MISC_OFF + 128 <= LDS_BYTES, "LDS map");

#define RLX_AGENT __ATOMIC_RELAXED, __HIP_MEMORY_SCOPE_AGENT
#define LDS_WAIT() asm volatile("s_waitcnt lgkmcnt(0)" ::: "memory")
#define VM_WAIT() asm volatile("s_waitcnt vmcnt(0)" ::: "memory")
__device__ __forceinline__ unsigned f2bf(float f) { unsigned u = __builtin_bit_cast(unsigned, f); return (u + 0x7fffu + ((u >> 16) & 1u)) >> 16; }
__device__ __forceinline__ unsigned pk2(float lo, float hi) { return f2bf(lo) | (f2bf(hi) << 16); }
__device__ __forceinline__ float bflo(unsigned w) { return __builtin_bit_cast(float, w << 16); }
__device__ __forceinline__ float bfhi(unsigned w) { return __builtin_bit_cast(float, w & 0xffff0000u); }
__device__ __forceinline__ unsigned cvt_pk_bf16(float lo, float hi) { unsigned r; asm volatile("v_cvt_pk_bf16_f32 %0, %1, %2" : "=v"(r) : "v"(lo), "v"(hi)); return r; }
__device__ __forceinline__ float wave_sum(float v) {
#pragma unroll
    for (int o = 1; o < 64; o <<= 1) v += __shfl_xor(v, o);
    return v;
}
__device__ __forceinline__ int opaque_tid() { int t = threadIdx.x; asm volatile("" : "+v"(t)); return t; }
__device__ __forceinline__ float fast_sigmoid(float x) { return __builtin_amdgcn_rcpf(1.f + __expf(-x)); }
__device__ __forceinline__ float gelu_tanh(float x) { return x * fast_sigmoid(1.5957691216057308f * (x + 0.044715f * x * x * x)); }

#define XB_TMO      128
#define XB_XCNT(j)  (256  + 64 * (j))
#define XB_XSUB(j)  (1280 + 64 * (j))
#define XB_XGEN(j)  (2304 + 64 * (j))
#define XB_TOP      3328
#define XB_TOPGEN   3392
#define XCD_BAR_WORDS 3456
#define XB_SPIN_CAP (1u << 22)
__device__ __forceinline__ unsigned xb_ld(unsigned* p)              { return __hip_atomic_load(p, __ATOMIC_RELAXED, __HIP_MEMORY_SCOPE_AGENT); }
__device__ __forceinline__ unsigned xb_add(unsigned* p, unsigned v) { return __hip_atomic_fetch_add(p, v, __ATOMIC_RELAXED, __HIP_MEMORY_SCOPE_AGENT); }
__device__ __forceinline__ unsigned xb_xcc_id() { return (unsigned)__builtin_amdgcn_s_getreg((3 << 11) | 20) & 0xFu; }
#define XB_SPIN(cond, bar) do { unsigned _sp = 0; while (cond) { __builtin_amdgcn_s_sleep(1); \
    if ((++_sp & 255u) == 0u) { if (xb_ld(&(bar)[XB_TMO])) break; if (_sp > XB_SPIN_CAP) { atomicAdd(&(bar)[XB_TMO], 1u); break; } } } } while (0)
struct XcdBarrier { unsigned* bar; unsigned x; volatile LAS unsigned* st; };
__device__ __forceinline__ XcdBarrier xcd_barrier_post(unsigned* bar, volatile LAS unsigned* st) {
    XcdBarrier b; b.bar = bar; b.x = xb_xcc_id(); b.st = st;
    if (threadIdx.x == 0) (void)xb_add(&bar[XB_XCNT(b.x)], 1u);
    return b;
}
__device__ __forceinline__ void xcd_barrier_complete(unsigned* bar, unsigned x, unsigned& nloc, unsigned& nx) {
    const unsigned G = gridDim.x * gridDim.y * gridDim.z;
    unsigned sum, cnt, mine, sp = 0u;
    for (;;) {
        sum = 0u; cnt = 0u; mine = 0u;
#pragma unroll
        for (unsigned j = 0; j < 16; ++j) { const unsigned c = xb_ld(&bar[XB_XCNT(j)]); sum += c; cnt += (c > 0u) ? 1u : 0u; mine = (j == x) ? c : mine; }
        if (sum == G) break;
        __builtin_amdgcn_s_sleep(1);
        if ((++sp & 255u) == 0u) { if (xb_ld(&bar[XB_TMO])) break; if (sp > XB_SPIN_CAP) { atomicAdd(&bar[XB_TMO], 1u); break; } }
    }
    nloc = mine > 0u ? mine : 1u; nx = cnt > 0u ? cnt : 1u;
}
__device__ __forceinline__ void xcd_barrier(const XcdBarrier& b) {
    asm volatile("s_waitcnt vmcnt(0)" ::: "memory");
    __syncthreads();
    if (threadIdx.x == 0) {
        unsigned* bar = b.bar;
        __builtin_amdgcn_s_waitcnt(0);
        unsigned nloc = b.st[0], nx = b.st[1];
        if (nloc == 0u) { xcd_barrier_complete(bar, b.x, nloc, nx); b.st[0] = nloc; b.st[1] = nx; }
        const unsigned old = xb_add(&bar[XB_XSUB(b.x)], 1u);
        const unsigned gen = old / nloc;
        if (old + 1u == (gen + 1u) * nloc) {
            __builtin_amdgcn_fence(__ATOMIC_RELEASE, "agent");
            asm volatile("s_waitcnt vmcnt(0)" ::: "memory");
            const unsigned og = xb_add(&bar[XB_TOP], 1u);
            const unsigned tg = og / nx;
            if (og + 1u == (tg + 1u) * nx) xb_add(&bar[XB_TOPGEN], 1u);
            else XB_SPIN(xb_ld(&bar[XB_TOPGEN]) == tg, bar);
            __builtin_amdgcn_fence(__ATOMIC_ACQUIRE, "agent");
            xb_add(&bar[XB_XGEN(b.x)], 1u);
            asm volatile("s_waitcnt vmcnt(0)" ::: "memory");
        } else {
            XB_SPIN(xb_ld(&bar[XB_XGEN(b.x)]) == gen, bar);
            __builtin_amdgcn_fence(__ATOMIC_ACQUIRE, "agent");
            asm volatile("s_waitcnt vmcnt(0)" ::: "memory");
        }
    }
    __syncthreads();
}

namespace gp {
constexpr int BM = 256, BK = 64, HALF = 128, HTB = HALF * BK * 2, STAGE_BYTES = 8 * HTB, NXCD = 8, WGM = 8;
__device__ __forceinline__ int lds_byte(int r, int c) { const int st = (r >> 4) * 2 + (c >> 5), rr = r & 15, cc = c & 31, ob = rr * 64 + cc * 2; return st * 1024 + (ob ^ (((ob >> 9) & 1) << 5)); }
__device__ __forceinline__ void stage_rc(int b, int& R, int& C) { const int st = b / 1024, sb = b % 1024, swz = sb ^ (((sb >> 9) & 1) << 5); R = (st >> 1) * 16 + swz / 64; C = (st & 1) * 32 + (swz % 64) / 2; }
__device__ __forceinline__ int perm32(int rho) { const int n = rho >> 4, i = rho & 15; return 8 * (i >> 2) + 4 * n + (i & 3); }

enum { BT_STD = 0, BT_ALIAS = 1, BT_TOEP = 2 };
enum { F_FIRST = 1, F_LAST = 2, F_MID = 4 };
struct Seg { const char* A; const char* B; int nt, flags, u0, u1; };

template <bool AROWPERM = false>
__device__ __forceinline__ void set_layout(int lda, int ldb, int bt, int tid, unsigned (&voffA)[2], unsigned (&voffB)[2], long& hsA, long& hsB) {
#pragma unroll
    for (int i = 0; i < 2; ++i) { int R, C; stage_rc(tid * 16 + i * 8192, R, C); const int Rb = (R & ~31) + perm32(R & 31);
        const int Ra = AROWPERM ? ((R & ~63) + 4 * (R & 15) + ((R >> 4) & 3)) : R;
        voffA[i] = (unsigned)(Ra * lda + C) * 2u;
        voffB[i] = (bt == BT_TOEP) ? (unsigned)((Rb & 15) * (LROW * 2) + (7 - (Rb >> 4)) * 32 + C * 2) : (unsigned)(Rb * ldb + C) * 2u; }
    hsA = (long)HALF * lda * 2;
    hsB = (bt == BT_STD) ? (long)HALF * ldb * 2 : (bt == BT_ALIAS ? 0l : -256l);
}

template <class Epi, class Sched, bool SP2 = true, int PROBE = 0, bool FP8 = false, bool I8 = false, bool KREV = false>
__device__ __forceinline__ void gemm_phase(LAS unsigned char* lds, const Sched& S, const Epi& E) {
    int tid_ = threadIdx.x; asm volatile("" : "+v"(tid_));
    const int tid = tid_, wid = __builtin_amdgcn_readfirstlane(tid >> 6), lane = tid & 63, wr = wid >> 2, wc = wid & 3, fr = lane & 15, fq = lane >> 4;
    Seg cur, nxt; int si = 0;
    if (!S.next(0, cur)) return;
    unsigned voffA[2], voffB[2]; long hsA, hsB;
    S.layout(cur, tid, voffA, voffB, hsA, hsB);
    const unsigned ldsw = (unsigned)wid * 1024u;
    const unsigned ldsbase = (unsigned)__builtin_amdgcn_readfirstlane((int)(unsigned)(__UINTPTR_TYPE__)lds);
    const int aoff = lds_byte(wr * 64 + fr, fq * 8), boff = lds_byte(wc * 32 + fr, fq * 8);
#define G_SA(b, h) (((b) * 2 + (h)) * HTB)
#define G_SB(b, h) ((4 + (b) * 2 + (h)) * HTB)
#define G_STAGE(bufoff, gbase, voff) do { if constexpr (PROBE == 0) _Pragma("unroll") for (int _i = 0; _i < 2; ++_i) \
        { const unsigned _l = ldsbase + (unsigned)(bufoff) + ldsw + (unsigned)_i * 8192u; \
          asm volatile("s_mov_b32 m0, %2\n\ts_nop 0\n\tglobal_load_lds_dwordx4 %0, %1" :: "v"((voff)[_i]), "s"((const char*)(gbase)), "s"(_l) : "memory"); } } while (0)
#define G_CAT8(x0, x1) __builtin_shufflevector(__builtin_bit_cast(i32x4, x0), __builtin_bit_cast(i32x4, x1), 0, 1, 2, 3, 4, 5, 6, 7)
#define G_LDA(dst, b, h) do { if constexpr (FP8) { _Pragma("unroll") for (int m = 0; m < 4; ++m) dst##8[m] = G_CAT8(*(const LAS bf16x8*)(lds + G_SA(b, h) + aoff + m * 2048), *(const LAS bf16x8*)(lds + G_SA(b, h) + aoff + m * 2048 + 1024)); } \
        else if constexpr (PROBE < 2) _Pragma("unroll") for (int m = 0; m < 4; ++m) _Pragma("unroll") for (int k = 0; k < 2; ++k) dst[m][k] = *(const LAS bf16x8*)(lds + G_SA(b, h) + aoff + m * 2048 + k * 1024); } while (0)
#define G_LDB(dst, b, h) do { if constexpr (FP8) { _Pragma("unroll") for (int n = 0; n < 2; ++n) dst##8[n] = G_CAT8(*(const LAS bf16x8*)(lds + G_SB(b, h) + boff + n * 2048), *(const LAS bf16x8*)(lds + G_SB(b, h) + boff + n * 2048 + 1024)); } \
        else if constexpr (PROBE < 2) _Pragma("unroll") for (int n = 0; n < 2; ++n) _Pragma("unroll") for (int k = 0; k < 2; ++k) dst[n][k] = *(const LAS bf16x8*)(lds + G_SB(b, h) + boff + n * 2048 + k * 1024); } while (0)
#define G_MMA(ai, bj, At, Bt) do { __builtin_amdgcn_s_setprio(1); \
        if constexpr (FP8) { _Pragma("unroll") for (int m = 0; m < 4; ++m) _Pragma("unroll") for (int n = 0; n < 2; ++n) \
            asm volatile("v_mfma_scale_f32_16x16x128_f8f6f4 %0, %1, %2, %0, %3, %3 op_sel_hi:[0,0,0]" : "+v"(acc[ai][bj][m][n]) : "v"(Bt##8[n]), "v"(At##8[m]), "v"(fp8_unit_scale)); } \
        else if constexpr (I8) { _Pragma("unroll") for (int k = 0; k < 2; ++k) _Pragma("unroll") for (int m = 0; m < 4; ++m) _Pragma("unroll") for (int n = 0; n < 2; ++n) \
            asm volatile("v_mfma_i32_16x16x64_i8 %0, %1, %2, %0" : "+v"(acc[ai][bj][m][n]) : "v"(Bt[n][k]), "v"(At[m][k])); } \
        else { _Pragma("unroll") for (int m = 0; m < 4; ++m) _Pragma("unroll") for (int n = 0; n < 2; ++n) _Pragma("unroll") for (int k = 0; k < 2; ++k) \
            acc[ai][bj][m][n] = __builtin_amdgcn_mfma_f32_16x16x32_bf16(Bt[n][k], At[m][k], acc[ai][bj][m][n], 0, 0, 0); } \
        __builtin_amdgcn_s_setprio(0); } while (0)
#define G_WAIT_V(n) asm volatile("s_waitcnt vmcnt(" #n ")" ::: "memory")
#define G_WAIT_L(n) asm volatile("s_waitcnt lgkmcnt(" #n ")" ::: "memory")
#define G_BAR do { if constexpr (PROBE < 3) __builtin_amdgcn_s_barrier(); } while (0)
#define G_SCHED __builtin_amdgcn_sched_barrier(0)
    f32x4 acc[2][2][4][2];
#pragma unroll
    for (int a = 0; a < 2; ++a)
#pragma unroll
        for (int b = 0; b < 2; ++b)
#pragma unroll
            for (int m = 0; m < 4; ++m)
#pragma unroll
                for (int n = 0; n < 2; ++n) acc[a][b][m][n] = (f32x4){0.f, 0.f, 0.f, 0.f};
    const int fp8_unit_scale = 0x7f7f7f7f;
    bf16x8 At[4][2], B0[2][2], B1[2][2]; i32x8 At8[4], B08[2], B18[2];
    if constexpr (PROBE >= 2) {
#pragma unroll
        for (int m = 0; m < 4; ++m)
#pragma unroll
            for (int k = 0; k < 2; ++k) { At[m][k] = (bf16x8){(short)(0x3c00 + tid), 1, 2, 3, 4, 5, 6, 7}; asm volatile("" : "+v"(At[m][k])); }
#pragma unroll
        for (int n = 0; n < 2; ++n)
#pragma unroll
            for (int k = 0; k < 2; ++k) { B0[n][k] = (bf16x8){(short)(0x3c10 + tid), 1, 2, 3, 4, 5, 6, 7}; B1[n][k] = B0[n][k]; asm volatile("" : "+v"(B0[n][k]), "+v"(B1[n][k])); }
    }
    const char* cA = cur.A; const char* cB = cur.B;
    constexpr long kstep = KREV ? -(long)(BK * 2) : (long)(BK * 2);
    if constexpr (SP2) {
    G_STAGE(G_SB(0, 0), cB, voffB); G_STAGE(G_SB(0, 1), cB + hsB, voffB); G_STAGE(G_SA(0, 0), cA, voffA); G_STAGE(G_SA(0, 1), cA + hsA, voffA);
    if (wr == 1) G_BAR;
    G_WAIT_V(2); G_BAR;
    G_STAGE(G_SB(1, 0), cB + kstep, voffB); G_STAGE(G_SA(1, 0), cA + kstep, voffA); G_STAGE(G_SB(1, 1), cB + hsB + kstep, voffB);
    G_WAIT_V(6); G_BAR;
    } else {
    G_STAGE(G_SB(0, 0), cB, voffB); G_STAGE(G_SA(0, 0), cA, voffA); G_STAGE(G_SB(0, 1), cB + hsB, voffB); G_STAGE(G_SA(0, 1), cA + hsA, voffA);
    if (wr == 1) G_BAR;
    G_WAIT_V(4); G_BAR;
    G_STAGE(G_SB(1, 0), cB + kstep, voffB); G_STAGE(G_SA(1, 0), cA + kstep, voffA); G_STAGE(G_SB(1, 1), cB + hsB + kstep, voffB);
    G_WAIT_V(6); G_BAR;
    }
    for (;;) {
        const bool has_next = S.next(si + 1, nxt);
        const char* nA = has_next ? nxt.A : cA; const char* nB = has_next ? nxt.B : cB;
        const int nt = (Sched::FIXED_NT > 0) ? Sched::FIXED_NT : cur.nt;
#pragma nounroll
        for (int t = 0; t < nt; t += 2) {
            const bool last = (t == nt - 2);
            const char* a1 = cA + (long)(t + 1) * kstep;
            if constexpr (SP2) {
            G_LDB(B0, 0, 0); G_LDB(B1, 0, 1); G_SCHED; G_LDA(At, 0, 0); G_STAGE(G_SA(1, 1), a1 + hsA, voffA);
            if constexpr (Sched::LAYOUT_CHANGES) { if (last && has_next) S.layout(nxt, tid, voffA, voffB, hsA, hsB); }
            const char* a2 = last ? nA : cA + (long)(t + 2) * kstep; const char* b2 = last ? nB : cB + (long)(t + 2) * kstep;
            const char* a3 = a2 + kstep; const char* b3 = b2 + kstep;
            G_WAIT_V(8); G_WAIT_L(0); G_BAR; G_MMA(0, 0, At, B0); G_MMA(0, 1, At, B1); G_BAR; G_SCHED;
            G_LDA(At, 0, 1); G_STAGE(G_SB(0, 0), b2, voffB); G_STAGE(G_SB(0, 1), b2 + hsB, voffB); G_STAGE(G_SA(0, 0), a2, voffA);
            G_WAIT_V(8); G_WAIT_L(0); G_BAR; G_MMA(1, 0, At, B0); G_MMA(1, 1, At, B1); G_BAR; G_SCHED;
            G_LDB(B0, 1, 0); G_LDB(B1, 1, 1); G_SCHED; G_LDA(At, 1, 0); G_STAGE(G_SA(0, 1), a2 + hsA, voffA);
            G_WAIT_V(8); G_WAIT_L(0); G_BAR; G_MMA(0, 0, At, B0); G_MMA(0, 1, At, B1); G_BAR; G_SCHED;
            G_LDA(At, 1, 1); G_STAGE(G_SB(1, 0), b3, voffB); G_STAGE(G_SB(1, 1), b3 + hsB, voffB); G_STAGE(G_SA(1, 0), a3, voffA);
            G_WAIT_V(8); G_WAIT_L(0); G_BAR; G_MMA(1, 0, At, B0); G_MMA(1, 1, At, B1); G_BAR; G_SCHED;
                    } else {
            G_LDB(B0, 0, 0); G_SCHED; G_LDA(At, 0, 0); G_STAGE(G_SA(1, 1), a1 + hsA, voffA);
            if constexpr (Sched::LAYOUT_CHANGES) { if (last && has_next) S.layout(nxt, tid, voffA, voffB, hsA, hsB); }
            const char* a2 = last ? nA : cA + (long)(t + 2) * kstep; const char* b2 = last ? nB : cB + (long)(t + 2) * kstep;
            const char* a3 = a2 + kstep; const char* b3 = b2 + kstep;
            G_WAIT_L(8); G_BAR; G_WAIT_L(0); G_MMA(0, 0, At, B0); G_BAR; G_SCHED;
            G_LDB(B1, 0, 1); G_STAGE(G_SB(0, 0), b2, voffB);
            G_BAR; G_WAIT_L(0); G_MMA(0, 1, At, B1); G_BAR;
            G_LDA(At, 0, 1); G_STAGE(G_SA(0, 0), a2, voffA);
            G_BAR; G_WAIT_L(0); G_MMA(1, 0, At, B0); G_BAR; G_SCHED;
            G_STAGE(G_SB(0, 1), b2 + hsB, voffB);
            G_WAIT_V(6); G_BAR; G_MMA(1, 1, At, B1); G_BAR;
            G_LDB(B0, 1, 0); G_SCHED; G_LDA(At, 1, 0); G_STAGE(G_SA(0, 1), a2 + hsA, voffA);
            G_WAIT_L(8); G_BAR; G_WAIT_L(0); G_MMA(0, 0, At, B0); G_BAR; G_SCHED;
            G_LDB(B1, 1, 1); G_STAGE(G_SB(1, 0), b3, voffB);
            G_BAR; G_WAIT_L(0); G_MMA(0, 1, At, B1); G_BAR;
            G_LDA(At, 1, 1); G_STAGE(G_SA(1, 0), a3, voffA);
            G_BAR; G_WAIT_L(0); G_MMA(1, 0, At, B0); G_BAR; G_SCHED;
            G_STAGE(G_SB(1, 1), b3 + hsB, voffB);
            G_WAIT_V(6); G_BAR; G_MMA(1, 1, At, B1); G_BAR;
            }
        }
        if constexpr (FP8 || I8) asm volatile("s_nop 15\n\ts_nop 15" ::: "memory");
        const bool unit_end = (cur.flags & F_LAST) != 0;
        if constexpr (Epi::HAS_MID) E.mid(acc, cur, wr, wc, fr, fq);
        if (unit_end) {
            if (wr == 0) G_BAR;
            if constexpr (!Epi::AFTER_DRAIN) E(acc, cur, wr, wc, fr, fq);
        }
        if (!has_next) break;
        if (unit_end) {
#pragma unroll
            for (int a = 0; a < 2; ++a)
#pragma unroll
                for (int b = 0; b < 2; ++b)
#pragma unroll
                    for (int m = 0; m < 4; ++m)
#pragma unroll
                        for (int n = 0; n < 2; ++n) acc[a][b][m][n] = (f32x4){0.f, 0.f, 0.f, 0.f};
        }
        cur = nxt; cA = nA; cB = nB; ++si;
        if (unit_end) { if (wr == 1) G_BAR; }
    }
    G_WAIT_V(0);
    G_BAR;
    if constexpr (Epi::AFTER_DRAIN) E.fused(acc, cur, wr, wc, fr, fq, lds, wid, lane);
#undef G_SA
#undef G_SB
#undef G_STAGE
#undef G_LDA
#undef G_LDB
#undef G_MMA
#undef G_CAT8
#undef G_WAIT_V
#undef G_WAIT_L
#undef G_BAR
#undef G_SCHED
}

struct TileOrder {
    int nM, nN, nwg, G, c, wgm;
    __device__ __forceinline__ void init(int nM_, int nN_, int G_, int c_, int wgm_ = WGM) { nM = nM_; nN = nN_; nwg = nM * nN; G = G_; c = c_; wgm = wgm_; }
    __device__ __forceinline__ bool tile(int i, int& pm, int& pn) const {
        const long L = (long)i * G + c; if (L >= nwg) return false;
        int wgid = (int)L; { const int q = nwg / NXCD, r = nwg % NXCD, xcd = wgid % NXCD, off = wgid / NXCD; wgid = (xcd < r ? xcd * (q + 1) : r * (q + 1) + (xcd - r) * q) + off; }
        const int nig = wgm * nN, gid = wgid / nig, fm = gid * wgm, gsz = (nM - fm) < wgm ? (nM - fm) : wgm;
        pm = fm + ((wgid % nig) % gsz); pn = (wgid % nig) / gsz; return true;
    }
};
}

struct Args {
    const float* in[30]; float* out; unsigned char* ws;
};
struct Frame {
    LAS unsigned char* lds; volatile LAS unsigned* MISC; unsigned* ctl;
    int wave, vcu, G;
    unsigned char* ws; float* out;
};

template <int NTSEG, int NSEG, int LDA, int LDB, int MIDFLAG, bool AROWPERM = false> struct SchedStd {
    static constexpr bool LAYOUT_CHANGES = false; static constexpr int FIXED_NT = NTSEG;
    gp::TileOrder T; const char* A; const char* B;
    __device__ __forceinline__ bool next(int i, gp::Seg& s) const {
        const int ui = i / NSEG, sg = i - ui * NSEG; int pm, pn; if (!T.tile(ui, pm, pn)) return false;
        s.A = A + ((size_t)pm * 256 * LDA + (size_t)sg * NTSEG * 64) * 2; s.B = B + ((size_t)pn * 256 * LDB + (size_t)sg * NTSEG * 64) * 2;
        s.nt = NTSEG;
        s.flags = (sg == 0 ? gp::F_FIRST : 0) | (sg == NSEG - 1 ? gp::F_LAST : MIDFLAG); s.u0 = pm; s.u1 = pn; return true;
    }
    __device__ __forceinline__ void layout(const gp::Seg& s, int tid, unsigned (&voffA)[2], unsigned (&voffB)[2], long& hsA, long& hsB) const { gp::set_layout<AROWPERM>(LDA, LDB, gp::BT_STD, tid, voffA, voffB, hsA, hsB); }
};
template <int NTSEG, int LDA, int LDB, int PMASK, int NMASK> struct SchedHot {
    static constexpr bool LAYOUT_CHANGES = false; static constexpr int FIXED_NT = NTSEG;
    gp::TileOrder T; const char* A; const char* B;
    __device__ __forceinline__ bool next(int i, gp::Seg& s) const {
        int pm, pn; if (!T.tile(i, pm, pn)) return false;
        s.A = A + ((size_t)(pm & PMASK) * 256 * LDA) * 2; s.B = B + ((size_t)(pn & NMASK) * 256 * LDB) * 2;
        s.nt = NTSEG; s.flags = gp::F_FIRST | gp::F_LAST; s.u0 = pm; s.u1 = pn; return true;
    }
    __device__ __forceinline__ void layout(const gp::Seg& s, int tid, unsigned (&voffA)[2], unsigned (&voffB)[2], long& hsA, long& hsB) const { gp::set_layout(LDA, LDB, gp::BT_STD, tid, voffA, voffB, hsA, hsB); }
};
template <int NTSEG, int LDA, int LDB> struct SchedQuarter {
    static constexpr bool LAYOUT_CHANGES = false; static constexpr int FIXED_NT = NTSEG;
    int c; const char* A; const char* B;
    __device__ __forceinline__ bool next(int i, gp::Seg& s) const {
        if (i >= 4) return false;
        const int x = c & 7, w = c >> 3, pm = 16 * i + 2 * x + (w >> 4), pn = w & 15;
        s.A = A + ((size_t)pm * 256 * LDA) * 2; s.B = B + ((size_t)pn * 256 * LDB) * 2;
        s.nt = NTSEG; s.flags = gp::F_FIRST | gp::F_LAST; s.u0 = pm; s.u1 = pn; return true;
    }
    __device__ __forceinline__ void layout(const gp::Seg& s, int tid, unsigned (&voffA)[2], unsigned (&voffB)[2], long& hsA, long& hsB) const { gp::set_layout(LDA, LDB, gp::BT_STD, tid, voffA, voffB, hsA, hsB); }
};
struct SchedP2 {
    static constexpr bool LAYOUT_CHANGES = false; static constexpr int FIXED_NT = 0;
    int v; unsigned char* ws;
    __device__ __forceinline__ bool next(int i, gp::Seg& s) const {
        if (i > 0) return false;
        s.flags = gp::F_FIRST | gp::F_LAST;
        if (v < 128) { s.A = (const char*)(ws + WS_UG) + (size_t)v * 256 * UROW * 2; s.B = (const char*)(ws + WS_EG) + (size_t)v * 128 * 1024 * 2;
            s.nt = 16; s.u0 = v; s.u1 = 0; return true; }
        const int j = v - 128; s.nt = 64;
        if (j < 64) { const int pm = j >> 4, pn = j & 15; s.A = (const char*)(ws + WS_HM) + (size_t)pm * 256 * D * 2; s.B = (const char*)(ws + WS_WK) + (size_t)pn * 256 * D * 2; s.u0 = pm; s.u1 = pn; s.flags |= 1 << 8; return true; }
        const int jj = j - 64, pm = jj >> 4, pn = jj & 15; s.A = (const char*)(ws + WS_HM) + (size_t)pm * 256 * D * 2; s.B = (const char*)(ws + WS_WV) + (size_t)pn * 256 * D * 2; s.u0 = pm; s.u1 = pn; s.flags |= 2 << 8; return true;
    }
    __device__ __forceinline__ void layout(const gp::Seg& s, int tid, unsigned (&voffA)[2], unsigned (&voffB)[2], long& hsA, long& hsB) const { if (v < 128) gp::set_layout(UROW, 1024, gp::BT_ALIAS, tid, voffA, voffB, hsA, hsB); else gp::set_layout(D, D, gp::BT_STD, tid, voffA, voffB, hsA, hsB); }
};
struct SchedY {
    static constexpr bool LAYOUT_CHANGES = true; static constexpr int FIXED_NT = 0;
    int v, G; unsigned char* ws;
    __device__ __forceinline__ bool next(int i, gp::Seg& s) const {
        const int ui = i >> 1, sg = i & 1, j = ui * G + v; if (j >= NG * 4) return false;
        const int g = j >> 2, pn = (ui & 1) ? 3 - (j & 3) : (j & 3);
        s.u0 = g; s.u1 = pn;
        if (sg == 0) { s.A = (const char*)(ws + WS_UG) + (size_t)g * 256 * UROW * 2; s.B = (const char*)(ws + WS_LT) + (size_t)g * 16 * LROW * 2 + (63 - 16 * pn - 7 - 8 * 0) * 32;
            s.nt = 4 * (pn + 1); s.flags = gp::F_FIRST; }
        else { s.A = (const char*)(ws + WS_UG) + (size_t)g * 256 * UROW * 2 + 2048; s.B = (const char*)(ws + WS_FG) + ((size_t)g * 1024 + pn * 256) * 128 * 2;
            s.nt = 2; s.flags = gp::F_LAST; }
        return true;
    }
    __device__ __forceinline__ void layout(const gp::Seg& s, int tid, unsigned (&voffA)[2], unsigned (&voffB)[2], long& hsA, long& hsB) const { if (s.flags & gp::F_FIRST) gp::set_layout(UROW, 0, gp::BT_TOEP, tid, voffA, voffB, hsA, hsB); else gp::set_layout(UROW, 128, gp::BT_STD, tid, voffA, voffB, hsA, hsB); }
};
struct SchedAT {
    static constexpr bool LAYOUT_CHANGES = false; static constexpr int FIXED_NT = 8;
    int v; unsigned char* ws;
    __device__ __forceinline__ bool next(int i, gp::Seg& s) const {
        if (i > 1 || v >= 256) return false;
        const int b = v >> 6, h = (v >> 4) & 3, t = v & 15;
        s.nt = 8; s.flags = gp::F_FIRST | gp::F_LAST | (i << 8);
        if (i == 0) { s.A = (const char*)(ws + WS_KB) + (((size_t)b * NMEM) * D + h * HD); s.B = (const char*)(ws + WS_WQ) + (((size_t)t * 256) * D + h * HD); s.u0 = b * 1024 + h * 256; s.u1 = t * 256; }
        else { s.A = (const char*)(ws + WS_WO) + (((size_t)t * 256) * D + h * HD); s.B = (const char*)(ws + WS_VB) + (((size_t)b * NMEM) * D + h * HD); s.u0 = b * D + t * 256; s.u1 = h * 256; }
        return true;
    }
    __device__ __forceinline__ void layout(const gp::Seg& s, int tid, unsigned (&voffA)[2], unsigned (&voffB)[2], long& hsA, long& hsB) const { gp::set_layout(D / 2, D / 2, gp::BT_STD, tid, voffA, voffB, hsA, hsB); }
};
struct SchedS {
    static constexpr bool LAYOUT_CHANGES = false; static constexpr int FIXED_NT = 32;
    int v; unsigned char* ws;
    __device__ __forceinline__ bool next(int i, gp::Seg& s) const {
        if (i > 0 || v >= 256) return false;
        const int b = v >> 6, qt = (v >> 2) & 15, h = v & 3;
        s.A = (const char*)(ws + WS_X8) + (((size_t)b * SEQ + qt * 256) * D); s.B = (const char*)(ws + WS_WKB) + (((size_t)b * 1024 + h * 256) * D);
        s.nt = 32; s.flags = gp::F_FIRST | gp::F_LAST; s.u0 = b * NH + h; s.u1 = qt; return true;
    }
    __device__ __forceinline__ void layout(const gp::Seg& s, int tid, unsigned (&voffA)[2], unsigned (&voffB)[2], long& hsA, long& hsB) const { gp::set_layout(D / 2, D / 2, gp::BT_STD, tid, voffA, voffB, hsA, hsB); }
};
struct SchedAO {
    static constexpr bool LAYOUT_CHANGES = false; static constexpr int FIXED_NT = 8;
    gp::TileOrder T; unsigned char* ws;
    __device__ __forceinline__ bool next(int i, gp::Seg& s) const {
        int pm, pn; if (!T.tile(i, pm, pn)) return false;
        s.A = (const char*)(ws + WS_P) + ((size_t)pm * 256 * 1024); s.B = (const char*)(ws + WS_VWT) + (((size_t)(pm >> 4) * D + pn * 256) * 1024);
        s.nt = 8; s.flags = gp::F_FIRST | gp::F_LAST; s.u0 = pm; s.u1 = pn; return true;
    }
    __device__ __forceinline__ void layout(const gp::Seg& s, int tid, unsigned (&voffA)[2], unsigned (&voffB)[2], long& hsA, long& hsB) const { gp::set_layout(512, 512, gp::BT_STD, tid, voffA, voffB, hsA, hsB); }
};

#define EPI_ROW(ai, m) (128 * (ai) + 64 * wr + 16 * (m) + fr)
#define EPI_COL(bj) (128 * (bj) + 32 * wc + 8 * fq)
__device__ __forceinline__ u32x4 pack8(const f32x4& a, const f32x4& b) { u32x4 w; w.x = cvt_pk_bf16(a[0], a[1]); w.y = cvt_pk_bf16(a[2], a[3]); w.z = cvt_pk_bf16(b[0], b[1]); w.w = cvt_pk_bf16(b[2], b[3]); return w; }
__device__ __forceinline__ void unpack8(const u32x4& w, f32x4& a, f32x4& b) { a = (f32x4){bflo(w.x), bfhi(w.x), bflo(w.y), bfhi(w.y)}; b = (f32x4){bflo(w.z), bfhi(w.z), bflo(w.w), bfhi(w.w)}; }
__device__ __forceinline__ float sumsq8(const f32x4& a, const f32x4& b) { return (a[0] * a[0] + a[1] * a[1]) + (a[2] * a[2] + a[3] * a[3]) + (b[0] * b[0] + b[1] * b[1]) + (b[2] * b[2] + b[3] * b[3]); }
typedef f32x4 AccT[2][2][4][2];
__device__ __forceinline__ float fp8_clamp(float v) { return __builtin_amdgcn_fmed3f(v, -448.f, 448.f); }
__device__ __forceinline__ u32x2 pack8_fp8(const f32x4& a, const f32x4& b) { int w0 = __builtin_amdgcn_cvt_pk_fp8_f32(fp8_clamp(a[0]), fp8_clamp(a[1]), 0, false); w0 = __builtin_amdgcn_cvt_pk_fp8_f32(fp8_clamp(a[2]), fp8_clamp(a[3]), w0, true);
    int w1 = __builtin_amdgcn_cvt_pk_fp8_f32(fp8_clamp(b[0]), fp8_clamp(b[1]), 0, false); w1 = __builtin_amdgcn_cvt_pk_fp8_f32(fp8_clamp(b[2]), fp8_clamp(b[3]), w1, true); u32x2 r; r.x = (unsigned)w0; r.y = (unsigned)w1; return r; }
__device__ __forceinline__ void stg8(void* base, unsigned off, const u32x2& v) { *(u32x2*)((char*)base + off) = v; }
__device__ __forceinline__ float trunc16(float v) { return __uint_as_float(__float_as_uint(v) & 0xFFFF0000u); }
__device__ __forceinline__ unsigned q8(float v) { return (unsigned)(int)__builtin_rintf(__builtin_amdgcn_fmed3f(v, -127.f, 127.f)) & 255u; }
__device__ __forceinline__ u32x2 pack8_i8(const f32x4& a, const f32x4& b) { u32x2 r; r.x = q8(a[0]) | (q8(a[1]) << 8) | (q8(a[2]) << 16) | (q8(a[3]) << 24); r.y = q8(b[0]) | (q8(b[1]) << 8) | (q8(b[2]) << 16) | (q8(b[3]) << 24); return r; }
#ifndef MK_GLU_FP8
#define MK_GLU_FP8 0
#endif
constexpr bool GLU_FP8 = MK_GLU_FP8 != 0;
constexpr float S_X8 = 4.f, S_WKB8 = 32.f, S_P8 = 256.f, S_VWT8 = 32.f, S_Z8 = 4.f, S_GLU8 = 1024.f, S_KV8 = 16.f, S_WQ8 = 2048.f, S_WO8 = 2048.f;
__device__ __forceinline__ u32x4 ldg16(const void* base, unsigned off) { return *(const u32x4*)((const char*)base + off); }
__device__ __forceinline__ f32x4 ldg16f(const void* base, unsigned off) { return *(const f32x4*)((const char*)base + off); }
__device__ __forceinline__ void stg16(void* base, unsigned off, const u32x4& v) { *(u32x4*)((char*)base + off) = v; }
__device__ __forceinline__ void stg16f(void* base, unsigned off, const f32x4& v) { *(f32x4*)((char*)base + off) = v; }

struct EpiProj {
    static constexpr bool AFTER_DRAIN = false, HAS_MID = false;
    bf16* ug; bf16* pc;
    __device__ __forceinline__ void mid(AccT&, const gp::Seg&, int, int, int, int) const {}
    __device__ __forceinline__ void operator()(const AccT& acc, const gp::Seg& u, int wr, int wc, int fr, int fq) const {
        const int pm = u.u0, pn = u.u1;
        if (pn < 8) {
            const int b = pm >> 4, ch0 = (pm & 15) * 4;
#pragma unroll
            for (int ai = 0; ai < 2; ++ai)
#pragma unroll
                for (int m = 0; m < 4; ++m) { const int ch = ch0 + 2 * ai + wr, s = 16 * m + fr;
#pragma unroll
                    for (int bj = 0; bj < 2; ++bj) { const int c = 256 * pn + EPI_COL(bj), g = c >> 4, hi = c & 15;
                        stg16(ug, (unsigned)(((g * 256 + b * 64 + ch) * UROW + s * 16 + hi) * 2), pack8(acc[ai][bj][m][0], acc[ai][bj][m][1])); } }
        } else if (pn < 16) {
#pragma unroll
            for (int ai = 0; ai < 2; ++ai)
#pragma unroll
                for (int m = 0; m < 4; ++m) { const unsigned ro = (unsigned)(((256 * pm + EPI_ROW(ai, m)) * CW3 + 256 * (pn - 8)) * 2);
#pragma unroll
                    for (int bj = 0; bj < 2; ++bj) stg16(pc, ro + EPI_COL(bj) * 2, pack8(acc[ai][bj][m][0], acc[ai][bj][m][1])); }
        } else {
#pragma unroll
            for (int ai = 0; ai < 2; ++ai)
#pragma unroll
                for (int m = 0; m < 4; ++m) { const unsigned ro = (unsigned)(((256 * pm + EPI_ROW(ai, m)) * CW3 + CONVW + 128 * (pn - 16)) * 2);
                    stg16(pc, ro + EPI_COL(0) * 2, pack8(acc[ai][0][m][0] * acc[ai][1][m][0], acc[ai][0][m][1] * acc[ai][1][m][1])); }
        }
    }
};
struct EpiP2 {
    static constexpr bool AFTER_DRAIN = false, HAS_MID = false;
    float* sloc; bf16* kb; bf16* vt;
    __device__ __forceinline__ void mid(AccT&, const gp::Seg&, int, int, int, int) const {}
    __device__ __forceinline__ void operator()(const AccT& acc, const gp::Seg& u, int wr, int wc, int fr, int fq) const {
        const int kind = u.flags >> 8;
        if (kind == 0) {
#pragma unroll
            for (int ai = 0; ai < 2; ++ai)
#pragma unroll
                for (int m = 0; m < 4; ++m) { const unsigned ro = (unsigned)(((u.u0 * 256 + EPI_ROW(ai, m)) * 128 + EPI_COL(0)) * 4);
                    stg16f(sloc, ro, acc[ai][0][m][0]); stg16f(sloc, ro + 16, acc[ai][0][m][1]); }
        } else {
            bf16* base = (kind == 1) ? kb : vt; const int ldc = D;
#pragma unroll
            for (int ai = 0; ai < 2; ++ai)
#pragma unroll
                for (int m = 0; m < 4; ++m) { const unsigned ro = (unsigned)((256 * u.u0 + EPI_ROW(ai, m)) * ldc + 256 * u.u1);
#pragma unroll
                    for (int bj = 0; bj < 2; ++bj) stg8(base, ro + EPI_COL(bj), pack8_fp8(acc[ai][bj][m][0] * S_KV8, acc[ai][bj][m][1] * S_KV8)); }
        }
    }
};
struct EpiY {
    static constexpr bool AFTER_DRAIN = false, HAS_MID = false;
    const bf16* ug; const float* dd; bf16* z; unsigned char* z8;
    __device__ __forceinline__ void mid(AccT&, const gp::Seg&, int, int, int, int) const {}
    __device__ __forceinline__ void operator()(const AccT& acc, const gp::Seg& u, int wr, int wc, int fr, int fq) const {
        const int g = u.u0, pn = u.u1;
#pragma unroll
        for (int bj = 0; bj < 2; ++bj) { const int c = 256 * pn + EPI_COL(bj), t = c >> 4, ho = c & 15;
            const f32x4 d0 = *(const f32x4*)(dd + g * 16 + ho), d1 = *(const f32x4*)(dd + g * 16 + ho + 4);
#pragma unroll
            for (int ai = 0; ai < 2; ++ai)
#pragma unroll
                for (int m = 0; m < 4; ++m) { const int row = EPI_ROW(ai, m);
                    const u32x4 uw = ldg16(ug, (unsigned)(((g * 256 + row) * UROW + c) * 2)); f32x4 u0, u1; unpack8(uw, u0, u1);
                    f32x4 y0 = acc[ai][bj][m][0] + d0 * u0, y1 = acc[ai][bj][m][1] + d1 * u1;
#pragma unroll
                    for (int e = 0; e < 4; ++e) { y0[e] = gelu_tanh(y0[e]); y1[e] = gelu_tanh(y1[e]); }
                    const int tok = (row >> 6) * SEQ + (row & 63) * TCH + t;
                    stg16(z, (unsigned)((tok * SSMW + g * 16 + ho) * 2), pack8(y0, y1));
                    if constexpr (GLU_FP8) stg8(z8, (unsigned)(tok * SSMW + g * 16 + ho), pack8_fp8(y0 * S_Z8, y1 * S_Z8)); } }
    }
};
struct EpiGlu {
    static constexpr bool AFTER_DRAIN = false, HAS_MID = false;
    const bf16* z; const float* gb; bf16* mixed; float* rowss;
    __device__ __forceinline__ void mid(AccT&, const gp::Seg&, int, int, int, int) const {}
    __device__ __forceinline__ void operator()(const AccT& acc, const gp::Seg& u, int wr, int wc, int fr, int fq) const {
        const int pm = u.u0, pn = u.u1;
        f32x4 b0[2], b1[2];
#pragma unroll
        for (int bj = 0; bj < 2; ++bj) { const int c = 256 * pn + EPI_COL(bj); b0[bj] = *(const f32x4*)(gb + c); b1[bj] = *(const f32x4*)(gb + c + 4); }
#pragma unroll
        for (int ai = 0; ai < 2; ++ai)
#pragma unroll
            for (int m = 0; m < 4; ++m) { const int row = 256 * pm + EPI_ROW(ai, m); float ss = 0.f;
#pragma unroll
                for (int bj = 0; bj < 2; ++bj) { const int c = 256 * pn + EPI_COL(bj);
                    const u32x4 zw = ldg16(z, (unsigned)((row * SSMW + c) * 2)); f32x4 z0, z1; unpack8(zw, z0, z1);
                    f32x4 y0, y1;
#pragma unroll
                    for (int e = 0; e < 4; ++e) { y0[e] = z0[e] * fast_sigmoid(acc[ai][bj][m][0][e] * (GLU_FP8 ? 1.f / (S_Z8 * S_GLU8) : 1.f) + b0[bj][e]); y1[e] = z1[e] * fast_sigmoid(acc[ai][bj][m][1][e] * (GLU_FP8 ? 1.f / (S_Z8 * S_GLU8) : 1.f) + b1[bj][e]); }
                    ss += sumsq8(y0, y1);
                    stg16(mixed, (unsigned)((row * D + c) * 2), pack8(y0, y1)); }
                ss += __shfl_xor(ss, 16); ss += __shfl_xor(ss, 32);
                if (fq == 0) unsafeAtomicAdd(rowss + row, ss); }
    }
};
template <bool BASE_F32, bool HAS_MID_, bool WRITE_I8 = false> struct EpiRes {
    static constexpr bool AFTER_DRAIN = false, HAS_MID = HAS_MID_;
    const float* base; bf16* xb; float* rowss; const float* rss_mid; unsigned char* x8; unsigned char* a8; const float* rss_q;
    static constexpr float accscale = WRITE_I8 ? 1.f / (S_P8 * S_VWT8) : 1.f;
    __device__ __forceinline__ void mid(AccT& acc, const gp::Seg& u, int wr, int wc, int fr, int fq) const {
        const bool on = (u.flags & gp::F_MID) != 0;
#pragma unroll
        for (int ai = 0; ai < 2; ++ai)
#pragma unroll
            for (int m = 0; m < 4; ++m) { const int row = 256 * u.u0 + EPI_ROW(ai, m);
                const float r = on ? rsqrtf(__hip_atomic_load((float*)rss_mid + row, RLX_AGENT) * (1.f / SSMW) + EPS) : 1.f;
#pragma unroll
                for (int bj = 0; bj < 2; ++bj) { acc[ai][bj][m][0] = acc[ai][bj][m][0] * r; acc[ai][bj][m][1] = acc[ai][bj][m][1] * r; } }
    }
    __device__ __forceinline__ void operator()(const AccT& acc, const gp::Seg& u, int wr, int wc, int fr, int fq) const {
        const int pm = u.u0, pn = u.u1;
        if constexpr (BASE_F32) {
            f32x4 gi[2][2];
#pragma unroll
            for (int bj = 0; bj < 2; ++bj)
#pragma unroll
                for (int n = 0; n < 2; ++n) { const f32x4 g = *(const f32x4*)(base + 256 * pn + EPI_COL(bj) + 4 * n); gi[bj][n] = (f32x4){1.f / g[0], 1.f / g[1], 1.f / g[2], 1.f / g[3]}; }
#pragma unroll
            for (int ai = 0; ai < 2; ++ai) {
                u32x4 bw[4][2];
#pragma unroll
                for (int m = 0; m < 4; ++m)
#pragma unroll
                    for (int bj = 0; bj < 2; ++bj) bw[m][bj] = ldg16(xb, (unsigned)((256 * pm + EPI_ROW(ai, m)) * D + 256 * pn + EPI_COL(bj)) * 2u);
#pragma unroll
                for (int m = 0; m < 4; ++m) { const int row = 256 * pm + EPI_ROW(ai, m); float ss = 0.f; const float xr = rss_q[row];
#pragma unroll
                    for (int bj = 0; bj < 2; ++bj) { const unsigned off = (unsigned)(row * D + 256 * pn + EPI_COL(bj)); f32x4 b0, b1; unpack8(bw[m][bj], b0, b1);
                        const f32x4 x0 = b0 * (gi[bj][0] * xr) + acc[ai][bj][m][0], x1 = b1 * (gi[bj][1] * xr) + acc[ai][bj][m][1];
                        ss += sumsq8(x0, x1);
                        stg16(xb, off * 2, pack8(x0, x1)); stg8(x8, off, pack8_fp8(x0 * S_X8, x1 * S_X8)); }
                    ss += __shfl_xor(ss, 16); ss += __shfl_xor(ss, 32);
                    if (fq == 0) unsafeAtomicAdd(rowss + row, ss); }
                asm volatile("" ::: "memory"); }
        } else {
            constexpr int NB = WRITE_I8 ? 2 : 1;
#pragma unroll
            for (int hb = 0; hb < NB; ++hb) {
                u32x4 bw[2][4][2];
#pragma unroll
                for (int ai = hb * (2 / NB) ; ai < (hb + 1) * (2 / NB); ++ai)
#pragma unroll
                    for (int m = 0; m < 4; ++m)
#pragma unroll
                        for (int bj = 0; bj < 2; ++bj) bw[ai][m][bj] = ldg16(xb, (unsigned)((256 * pm + EPI_ROW(ai, m)) * D + 256 * pn + EPI_COL(bj)) * 2u);
#pragma unroll
                for (int ai = hb * (2 / NB); ai < (hb + 1) * (2 / NB); ++ai)
#pragma unroll
                    for (int m = 0; m < 4; ++m) { const int row = 256 * pm + EPI_ROW(ai, m); float ss = 0.f; float qinv = 0.f;
                        if constexpr (WRITE_I8) qinv = (127.f / QCLIP) * rsqrtf(trunc16(__hip_atomic_load((float*)rss_q + row, RLX_AGENT)) * (1.f / D) + EPS);
#pragma unroll
                        for (int bj = 0; bj < 2; ++bj) { const unsigned off = (unsigned)(row * D + 256 * pn + EPI_COL(bj)); f32x4 b0, b1; unpack8(bw[ai][m][bj], b0, b1);
                            const f32x4 x0 = b0 + acc[ai][bj][m][0] * accscale, x1 = b1 + acc[ai][bj][m][1] * accscale;
                            ss += sumsq8(x0, x1);
                            stg16(xb, off * 2, pack8(x0, x1));
                            if constexpr (WRITE_I8) stg8(a8, off, pack8_i8(x0 * qinv, x1 * qinv)); }
                        ss += __shfl_xor(ss, 16); ss += __shfl_xor(ss, 32);
                        if (fq == 0) unsafeAtomicAdd(rowss + row, ss); }
            }
        }
    }
};
struct EpiScaleBf {
    static constexpr bool AFTER_DRAIN = false, HAS_MID = false;
    const float* rowss; bf16* o; int ldc;
    __device__ __forceinline__ void mid(AccT&, const gp::Seg&, int, int, int, int) const {}
    __device__ __forceinline__ void operator()(const AccT& acc, const gp::Seg& u, int wr, int wc, int fr, int fq) const {
        const int pm = u.u0, pn = u.u1;
#pragma unroll
        for (int ai = 0; ai < 2; ++ai)
#pragma unroll
            for (int m = 0; m < 4; ++m) { const int row = 256 * pm + EPI_ROW(ai, m);
                const float r = rsqrtf(__hip_atomic_load((float*)rowss + row, RLX_AGENT) * (1.f / D) + EPS);
                const unsigned ro = (unsigned)(row * ldc + 256 * pn) * 2u;
#pragma unroll
                for (int bj = 0; bj < 2; ++bj) stg16(o, ro + EPI_COL(bj) * 2, pack8(acc[ai][bj][m][0] * r, acc[ai][bj][m][1] * r)); }
    }
};
template <int CTRL> __device__ __forceinline__ float dpp_f(float old, float src) { return __builtin_bit_cast(float, __builtin_amdgcn_update_dpp(__builtin_bit_cast(int, old), __builtin_bit_cast(int, src), CTRL, 0xf, 0xf, false)); }
template <int CTRL> __device__ __forceinline__ float dpp_rot(float src) { return __builtin_bit_cast(float, __builtin_amdgcn_mov_dpp(__builtin_bit_cast(int, src), CTRL, 0xf, 0xf, false)); }
#define FFN_TOK(ai, m) (128 * (ai) + 64 * wr + 4 * fr + (m))
struct EpiFfn {
    static constexpr bool AFTER_DRAIN = false, HAS_MID = false;
    const float* rowss; bf16* act; float* halo; const float* cw; const float* cb; LAS unsigned char* lds; const float* rss_q; const float* scb;
    __device__ __forceinline__ void mid(AccT&, const gp::Seg&, int, int, int, int) const {}
    __device__ __forceinline__ void operator()(AccT& acc, const gp::Seg& u, int wr, int wc, int fr, int fq) const {
        const int pm = u.u0, pn = u.u1, cl = 32 * wc + 8 * fq, ch = 128 * pn + cl;
        LAS float* EX = (LAS float*)(lds + EX_OFF);
        f32x4 sb[2][2];
#pragma unroll
        for (int bj = 0; bj < 2; ++bj)
#pragma unroll
            for (int n = 0; n < 2; ++n) sb[bj][n] = *(const f32x4*)(scb + 256 * pn + 128 * bj + cl + 4 * n);
#pragma unroll
        for (int ai = 0; ai < 2; ++ai)
#pragma unroll
            for (int m = 0; m < 4; ++m) { const int row = 256 * pm + FFN_TOK(ai, m);
                const float r = rsqrtf(__hip_atomic_load((float*)rowss + row, RLX_AGENT) * (1.f / D) + EPS) * (QCLIP / 127.f) * sqrtf(trunc16(__hip_atomic_load((float*)rss_q + row, RLX_AGENT)) * (1.f / D) + EPS);
#pragma unroll
                for (int bj = 0; bj < 2; ++bj)
#pragma unroll
                    for (int n = 0; n < 2; ++n)
#pragma unroll
                        for (int e = 0; e < 4; ++e) { const float f = acc[ai][bj][m][n][e]; acc[ai][bj][m][n][e] = (float)__float_as_int(f) * r * sb[bj][n][e]; } }
#pragma unroll
        for (int ai = 0; ai < 2; ++ai) { const int blk = 2 * ai + wr;
            if (fr == 15) {
#pragma unroll
                for (int k = 0; k < 2; ++k) {
                    if (blk < 3) { LAS float* d = EX + (blk * 2 + k) * 128 + cl; *(LAS f32x4*)d = acc[ai][0][2 + k][0]; *(LAS f32x4*)(d + 4) = acc[ai][0][2 + k][1]; }
                    else { float* d = halo + ((size_t)(4 + k) * 64 + pm) * DFF + ch; *(f32x4*)d = acc[ai][0][2 + k][0]; *(f32x4*)(d + 4) = acc[ai][0][2 + k][1]; } } }
            if (blk == 0 && fr == 0) {
#pragma unroll
                for (int k = 0; k < 2; ++k) { float* d = halo + ((size_t)k * 64 + pm) * DFF + ch; *(f32x4*)d = acc[0][0][k][0]; *(f32x4*)(d + 4) = acc[0][0][k][1];
                    float* e = halo + ((size_t)(2 + k) * 64 + pm) * DFF + ch; *(f32x4*)e = acc[0][1][k][0]; *(f32x4*)(e + 4) = acc[0][1][k][1]; } } }
        LDS_WAIT(); __builtin_amdgcn_s_barrier(); asm volatile("" ::: "memory");
        f32x4 w0[2], w1[2], w2[2], bb[2];
#pragma unroll
        for (int n = 0; n < 2; ++n) { w0[n] = *(const f32x4*)(cw + ch + 4 * n); w1[n] = *(const f32x4*)(cw + DFF + ch + 4 * n); w2[n] = *(const f32x4*)(cw + 2 * DFF + ch + 4 * n); bb[n] = *(const f32x4*)(cb + ch + 4 * n); }
#pragma unroll
        for (int ai = 0; ai < 2; ++ai) { const int blk = 2 * ai + wr;
            f32x4 e2[2], e1[2];
            if (blk > 0) { const LAS float* sp = EX + ((blk - 1) * 2) * 128 + cl; e2[0] = *(const LAS f32x4*)sp; e2[1] = *(const LAS f32x4*)(sp + 4); e1[0] = *(const LAS f32x4*)(sp + 128); e1[1] = *(const LAS f32x4*)(sp + 132); }
            else { e2[0] = e2[1] = e1[0] = e1[1] = (f32x4){0.f, 0.f, 0.f, 0.f}; }
            f32x4 o[4][2];
#pragma unroll
            for (int n = 0; n < 2; ++n)
#pragma unroll
                for (int e = 0; e < 4; ++e) { const float a0 = acc[ai][0][0][n][e], a1 = acc[ai][0][1][n][e], a2 = acc[ai][0][2][n][e], a3 = acc[ai][0][3][n][e];
                    const float p3 = dpp_f<0x111>(e1[n][e], a3), p2 = dpp_f<0x111>(e2[n][e], a2);
                    const float k0 = w0[n][e], k1 = w1[n][e], k2 = w2[n][e], kb = bb[n][e];
                    const float s0 = __builtin_fmaf(k0, p2, __builtin_fmaf(k1, p3, __builtin_fmaf(k2, a0, kb)));
                    const float s1 = __builtin_fmaf(k0, p3, __builtin_fmaf(k1, a0, __builtin_fmaf(k2, a1, kb)));
                    const float s2 = __builtin_fmaf(k0, a0, __builtin_fmaf(k1, a1, __builtin_fmaf(k2, a2, kb)));
                    const float s3 = __builtin_fmaf(k0, a1, __builtin_fmaf(k1, a2, __builtin_fmaf(k2, a3, kb)));
                    o[0][n][e] = s0 * fast_sigmoid(s0) * acc[ai][1][0][n][e]; o[1][n][e] = s1 * fast_sigmoid(s1) * acc[ai][1][1][n][e];
                    o[2][n][e] = s2 * fast_sigmoid(s2) * acc[ai][1][2][n][e]; o[3][n][e] = s3 * fast_sigmoid(s3) * acc[ai][1][3][n][e]; }
#pragma unroll
            for (int m = 0; m < 4; ++m) stg16(act, (unsigned)(((256 * pm + FFN_TOK(ai, m)) * DFF + ch) * 2), pack8(o[m][0], o[m][1])); }
    }
};
__device__ __forceinline__ void ffn_fixup_tile(const Frame& F, const Args& a, int pm) {
    if ((pm & 15) == 0) return;
    const float* cw = a.in[26]; const float* cb = a.in[27]; const float* halo = (const float*)(F.ws + WS_HALO); bf16* act = (bf16*)(F.ws + WS_ACT);
    for (int i = opaque_tid(); i < DFF / 4; i += NTHR) { const int c = i * 4;
        const f32x4 a0 = *(const f32x4*)(halo + ((size_t)0 * 64 + pm) * DFF + c), a1 = *(const f32x4*)(halo + ((size_t)1 * 64 + pm) * DFF + c);
        const f32x4 g0 = *(const f32x4*)(halo + ((size_t)2 * 64 + pm) * DFF + c), g1 = *(const f32x4*)(halo + ((size_t)3 * 64 + pm) * DFF + c);
        const f32x4 p2 = *(const f32x4*)(halo + ((size_t)4 * 64 + pm - 1) * DFF + c), p1 = *(const f32x4*)(halo + ((size_t)5 * 64 + pm - 1) * DFF + c);
        const f32x4 w0 = *(const f32x4*)(cw + c), w1 = *(const f32x4*)(cw + DFF + c), w2 = *(const f32x4*)(cw + 2 * DFF + c), bb = *(const f32x4*)(cb + c);
        f32x4 s0 = w0 * p2 + w1 * p1 + w2 * a0 + bb, s1 = w0 * p1 + w1 * a0 + w2 * a1 + bb;
#pragma unroll
        for (int e = 0; e < 4; ++e) { s0[e] = s0[e] * fast_sigmoid(s0[e]) * g0[e]; s1[e] = s1[e] * fast_sigmoid(s1[e]) * g1[e]; }
        u32x2 o0, o1; o0.x = cvt_pk_bf16(s0[0], s0[1]); o0.y = cvt_pk_bf16(s0[2], s0[3]); o1.x = cvt_pk_bf16(s1[0], s1[1]); o1.y = cvt_pk_bf16(s1[2], s1[3]);
        *(u32x2*)(act + (size_t)(256 * pm) * DFF + c) = o0; *(u32x2*)(act + (size_t)(256 * pm + 1) * DFF + c) = o1; }
}
struct EpiNull {
    static constexpr bool AFTER_DRAIN = false, HAS_MID = false;
    float* sink;
    __device__ __forceinline__ void mid(AccT&, const gp::Seg&, int, int, int, int) const {}
    __device__ __forceinline__ void operator()(const AccT& acc, const gp::Seg& u, int wr, int wc, int fr, int fq) const {
        f32x4 t = (f32x4){0.f, 0.f, 0.f, 0.f};
#pragma unroll
        for (int ai = 0; ai < 2; ++ai)
#pragma unroll
            for (int bj = 0; bj < 2; ++bj)
#pragma unroll
                for (int m = 0; m < 4; ++m) { t = t + acc[ai][bj][m][0]; t = t + acc[ai][bj][m][1]; }
        if ((t[0] + t[1]) + (t[2] + t[3]) == 12345.678f) sink[0] = 1.f; }
};
struct EpiAT {
    static constexpr bool AFTER_DRAIN = false, HAS_MID = false;
    bf16* wkb; bf16* vwt;
    __device__ __forceinline__ void mid(AccT&, const gp::Seg&, int, int, int, int) const {}
    __device__ __forceinline__ void operator()(const AccT& acc, const gp::Seg& u, int wr, int wc, int fr, int fq) const {
        const int kind = u.flags >> 8; bf16* o = kind ? vwt : wkb; const int ldc = kind ? 1024 : D; const float sc = kind ? S_VWT8 / (S_WO8 * S_KV8) : S_WKB8 / (S_KV8 * S_WQ8);
#pragma unroll
        for (int ai = 0; ai < 2; ++ai)
#pragma unroll
            for (int m = 0; m < 4; ++m) { const unsigned ro = (unsigned)((u.u0 + EPI_ROW(ai, m)) * ldc + u.u1);
#pragma unroll
                for (int bj = 0; bj < 2; ++bj) stg8(o, ro + EPI_COL(bj), pack8_fp8(acc[ai][bj][m][0] * sc, acc[ai][bj][m][1] * sc)); }
    }
};
struct EpiSoftmax {
    static constexpr bool AFTER_DRAIN = true, HAS_MID = false;
    bf16* P; const float* rowss;
    __device__ __forceinline__ void mid(AccT&, const gp::Seg&, int, int, int, int) const {}
    __device__ __forceinline__ void operator()(const AccT&, const gp::Seg&, int, int, int, int) const {}
    __device__ __forceinline__ void fused(AccT& acc, const gp::Seg& u, int wr, int wc, int fr, int fq, LAS unsigned char* lds, int wid, int lane) const {
        LAS float* Tm = (LAS float*)lds;
        LAS float* Ts = (LAS float*)(lds + 4096);
        const float sc = 0.03125f * 1.4426950408889634f;
        const int b = u.u0 >> 2, h = u.u0 & 3, qt = u.u1;
#pragma unroll
        for (int ai = 0; ai < 2; ++ai)
#pragma unroll
            for (int m = 0; m < 4; ++m) { float mx = -3.0e38f;
                const float r = rsqrtf(__hip_atomic_load((float*)rowss + b * SEQ + qt * 256 + EPI_ROW(ai, m), RLX_AGENT) * (1.f / D) + EPS) * (1.f / (S_X8 * S_WKB8));
#pragma unroll
                for (int bj = 0; bj < 2; ++bj) { acc[ai][bj][m][0] = acc[ai][bj][m][0] * r; acc[ai][bj][m][1] = acc[ai][bj][m][1] * r; }
#pragma unroll
                for (int bj = 0; bj < 2; ++bj)
#pragma unroll
                    for (int n = 0; n < 2; ++n)
#pragma unroll
                        for (int e = 0; e < 4; ++e) mx = fmaxf(mx, acc[ai][bj][m][n][e]);
                mx = fmaxf(mx, __shfl_xor(mx, 16)); mx = fmaxf(mx, __shfl_xor(mx, 32));
                if (fq == 0) Tm[EPI_ROW(ai, m) * 4 + wc] = mx; }
        LDS_WAIT(); __builtin_amdgcn_s_barrier(); asm volatile("" ::: "memory");
#pragma unroll
        for (int ai = 0; ai < 2; ++ai)
#pragma unroll
            for (int m = 0; m < 4; ++m) { const f32x4 t = *(const LAS f32x4*)(Tm + EPI_ROW(ai, m) * 4); const float mx = fmaxf(fmaxf(t[0], t[1]), fmaxf(t[2], t[3])); float s = 0.f;
#pragma unroll
                for (int bj = 0; bj < 2; ++bj)
#pragma unroll
                    for (int n = 0; n < 2; ++n)
#pragma unroll
                        for (int e = 0; e < 4; ++e) { const float p = __builtin_amdgcn_exp2f((acc[ai][bj][m][n][e] - mx) * sc); acc[ai][bj][m][n][e] = p; s += p; }
                s += __shfl_xor(s, 16); s += __shfl_xor(s, 32);
                if (fq == 0) Ts[EPI_ROW(ai, m) * 4 + wc] = s; }
        LDS_WAIT(); __builtin_amdgcn_s_barrier(); asm volatile("" ::: "memory");
#pragma unroll
        for (int ai = 0; ai < 2; ++ai)
#pragma unroll
            for (int m = 0; m < 4; ++m) { const f32x4 t = *(const LAS f32x4*)(Ts + EPI_ROW(ai, m) * 4); const float inv = S_P8 / ((t[0] + t[1]) + (t[2] + t[3]));
                const unsigned ro = (unsigned)((b * SEQ + qt * 256 + EPI_ROW(ai, m)) * 1024 + h * 256);
#pragma unroll
                for (int bj = 0; bj < 2; ++bj) stg8(P, ro + EPI_COL(bj), pack8_fp8(acc[ai][bj][m][0] * inv, acc[ai][bj][m][1] * inv)); }
        LDS_WAIT(); __builtin_amdgcn_s_barrier(); asm volatile("" ::: "memory");
    }
};

template <bool FFN_PERM = false, bool OUT_FP8 = false>
__device__ __forceinline__ void p0_transpose_item(const float* W, int K, int N, bf16* WT, const float* gk, LAS float* scr, int item, int lane, float sc8 = 1.f) {
    const int nblk = N / 64, kb = item / nblk, nb = item - kb * nblk, k0 = 64 * kb, n0 = 64 * nb;
    const int d0 = FFN_PERM ? ((n0 < 2 * SSMW) ? n0 : (n0 < 3 * SSMW) ? 2 * SSMW + ((n0 - 2 * SSMW) / 128) * 256 + (n0 % 128) : 2 * SSMW + ((n0 - 3 * SSMW) / 128) * 256 + 128 + (n0 % 128)) : n0;
    const int lk = lane >> 4, ln = (lane & 15) * 4;
    f32x4 v[16];
#pragma unroll
    for (int i = 0; i < 16; ++i) v[i] = *(const f32x4*)(W + (size_t)(k0 + 4 * i + lk) * N + n0 + ln);
    if (gk) {
#pragma unroll
        for (int i = 0; i < 16; ++i) v[i] = v[i] * gk[k0 + 4 * i + lk];
    }
#pragma unroll
    for (int i = 0; i < 16; ++i) { LAS float* d = scr + (4 * i + lk) * 65 + ln; d[0] = v[i].x; d[1] = v[i].y; d[2] = v[i].z; d[3] = v[i].w; }
    LDS_WAIT(); asm volatile("" ::: "memory");
    const int c = lane & 7;
#pragma unroll
    for (int j = 0; j < 8; ++j) { const int n = (lane >> 3) + 8 * j; const LAS float* s = scr + (8 * c) * 65 + n;
        if constexpr (OUT_FP8) { const f32x4 lo = (f32x4){s[0 * 65], s[1 * 65], s[2 * 65], s[3 * 65]} * sc8, hi = (f32x4){s[4 * 65], s[5 * 65], s[6 * 65], s[7 * 65]} * sc8;
            *(u32x2*)((unsigned char*)WT + (size_t)(d0 + n) * K + k0 + 8 * c) = pack8_fp8(lo, hi); }
        else { u32x4 o; o.x = pk2(s[0 * 65], s[1 * 65]); o.y = pk2(s[2 * 65], s[3 * 65]); o.z = pk2(s[4 * 65], s[5 * 65]); o.w = pk2(s[6 * 65], s[7 * 65]);
            *(u32x4*)(WT + (size_t)(d0 + n) * K + k0 + 8 * c) = o; } }
    LDS_WAIT(); asm volatile("" ::: "memory");
}
constexpr int WUP_KSUB = 8;
__device__ __forceinline__ void wup_colmax_item(const float* W, const float* gk, float* colss, int item, int lane) {
    constexpr int N = 2 * DFF, nblk = N / 64; const int kq = item / nblk, nb = item - kq * nblk, kb = WUP_KSUB * kq, k0 = 64 * kb, n0 = 64 * nb, lk = lane >> 4, ln = (lane & 15) * 4;
    f32x4 v[16];
#pragma unroll
    for (int i = 0; i < 16; ++i) v[i] = *(const f32x4*)(W + (size_t)(k0 + 4 * i + lk) * N + n0 + ln);
    f32x4 sq = (f32x4){0.f, 0.f, 0.f, 0.f};
#pragma unroll
    for (int i = 0; i < 16; ++i) { const f32x4 a = v[i] * gk[k0 + 4 * i + lk]; sq = sq + a * a; }
#pragma unroll
    for (int e = 0; e < 4; ++e) { float m = sq[e]; m += __shfl_xor(m, 16); m += __shfl_xor(m, 32); if (lane < 16) unsafeAtomicAdd(colss + n0 + ln + e, m); }
}
__device__ __forceinline__ void wup_quant_item(const float* W, const float* gk, const float* colss, unsigned char* W8, float* scb, LAS float* scr, int item, int lane) {
    constexpr int K = D, N = 2 * DFF, nblk = N / 64; const int kb = item / nblk, nb = item - kb * nblk, k0 = 64 * kb, n0 = 64 * nb;
    const int d0 = (n0 < DFF) ? (n0 / 128) * 256 + (n0 % 128) : ((n0 - DFF) / 128) * 256 + 128 + ((n0 - DFF) % 128);
    const int lk = lane >> 4, ln = (lane & 15) * 4;
    f32x4 v[16];
#pragma unroll
    for (int i = 0; i < 16; ++i) v[i] = *(const f32x4*)(W + (size_t)(k0 + 4 * i + lk) * N + n0 + ln);
#pragma unroll
    for (int i = 0; i < 16; ++i) v[i] = v[i] * gk[k0 + 4 * i + lk];
#pragma unroll
    for (int i = 0; i < 16; ++i) { LAS float* d = scr + (4 * i + lk) * 65 + ln; d[0] = v[i].x; d[1] = v[i].y; d[2] = v[i].z; d[3] = v[i].w; }
    LDS_WAIT(); asm volatile("" ::: "memory");
    if (kb == 0) scb[d0 + lane] = (QCLIPW / 127.f) * sqrtf(trunc16(__hip_atomic_load((float*)colss + n0 + lane, RLX_AGENT)) * ((float)WUP_KSUB / K) + 1e-30f);
    const int c = lane & 7;
#pragma unroll
    for (int j = 0; j < 8; ++j) { const int n = (lane >> 3) + 8 * j; const LAS float* s = scr + (8 * c) * 65 + n;
        const float inv = (127.f / QCLIPW) * rsqrtf(trunc16(__hip_atomic_load((float*)colss + n0 + n, RLX_AGENT)) * ((float)WUP_KSUB / K) + 1e-30f);
        const f32x4 lo = (f32x4){s[0 * 65], s[1 * 65], s[2 * 65], s[3 * 65]} * inv, hi = (f32x4){s[4 * 65], s[5 * 65], s[6 * 65], s[7 * 65]} * inv;
        *(u32x2*)(W8 + (size_t)(d0 + n) * K + k0 + 8 * c) = pack8_i8(lo, hi); }
    LDS_WAIT(); asm volatile("" ::: "memory");
}
__device__ __forceinline__ void rms_row_to_bf16(const float* xrow, const float* g, bf16* orow, int lane, float* rinv = nullptr) {
    const f32x4* xr = (const f32x4*)xrow + lane; const f32x4* gr = (const f32x4*)g + lane;
    f32x4 v[16]; float s = 0.f;
#pragma unroll
    for (int j = 0; j < 16; ++j) { v[j] = xr[64 * j]; s += (v[j].x * v[j].x + v[j].y * v[j].y) + (v[j].z * v[j].z + v[j].w * v[j].w); }
    const float ms = wave_sum(s) * (1.f / D) + EPS, r = rsqrtf(ms);
    if (rinv && lane == 0) *rinv = ms * r;
    u32x2* o8 = (u32x2*)orow + lane;
#pragma unroll
    for (int j = 0; j < 16; ++j) { const f32x4 gg = gr[64 * j]; u32x2 w; w.x = pk2(v[j].x * r * gg.x, v[j].y * r * gg.y); w.y = pk2(v[j].z * r * gg.z, v[j].w * r * gg.w); o8[64 * j] = w; }
}

__device__ __forceinline__ void cvt_row_to_bf16(const float* wrow, float gain, bf16* orow, int lane) {
    const f32x4* xr = (const f32x4*)wrow + 2 * lane; u32x2* o8 = (u32x2*)orow + lane; f32x4 v[16];
#pragma unroll
    for (int j = 0; j < 8; ++j) { v[2 * j] = xr[128 * j]; v[2 * j + 1] = xr[128 * j + 1]; }
#pragma unroll
    for (int j = 0; j < 8; ++j) o8[64 * j] = pack8_fp8(v[2 * j] * gain, v[2 * j + 1] * gain);
}
__device__ __forceinline__ void ssm_tables_group(const Frame& F, const Args& a, int g, int part) {
    LAS float* pwr = (LAS float*)(F.lds);
    LAS float* pwi = pwr + 65 * 64;
    LAS float* bbr = pwi + 65 * 64;
    LAS float* bbi = bbr + 64 * 16;
    LAS float* ccr = bbi + 64 * 16;
    LAS float* cci = ccr + 16 * 64;
    LAS float* kk = cci + 16 * 64;
    LAS float* cfl = kk + 64 * 16 * 16;
    const float* lam_re = a.in[4]; const float* lam_im = a.in[5]; const float* log_step = a.in[6];
    const float* b_re = a.in[7]; const float* b_im = a.in[8]; const float* c_re = a.in[9]; const float* c_im = a.in[10];
    unsigned char* ws = F.ws; const int tid = opaque_tid();
    const double step = exp((double)log_step[g]);
    if (tid < 64) { const int p = tid; const double lr = lam_re[g * NP + p], li = lam_im[g * NP + p]; const double mg = exp(lr * step), an = li * step, ar = mg * cos(an), ai = mg * sin(an);
        { const double den = lr * lr + li * li, nr = ar - 1.0, ni = ai; cfl[p] = (float)((nr * lr + ni * li) / den); cfl[64 + p] = (float)((ni * lr - nr * li) / den); }
        double pr = 1.0, pi = 0.0;
        for (int j = 0; j <= 64; ++j) { pwr[j * 64 + p] = (float)pr; pwi[j * 64 + p] = (float)pi; const double nr = pr * ar - pi * ai, ni = pr * ai + pi * ar; pr = nr; pi = ni; } }
    for (int i = tid; i < 16 * 64; i += NTHR) { ccr[i] = c_re[(size_t)g * GH * NP + i]; cci[i] = c_im[(size_t)g * GH * NP + i]; }
    __syncthreads();
    for (int i = tid; i < 64 * 16; i += NTHR) { const int p = i >> 4; const float cfr = cfl[p], cfi = cfl[64 + p], br = b_re[(size_t)g * NP * GH + i], bi = b_im[(size_t)g * NP * GH + i];
        bbr[i] = cfr * br - cfi * bi; bbi[i] = cfr * bi + cfi * br; }
    __syncthreads();
    if (part != 1) {
    if (tid < 64) { float* a64 = (float*)(ws + WS_A64) + ((size_t)g * NP + tid) * 2; a64[0] = pwr[64 * 64 + tid]; a64[1] = pwi[64 * 64 + tid]; }
    for (int i = tid; i < 64 * 16; i += NTHR) { const int j = i >> 4, ho = i & 15; float acc[16];
#pragma unroll
        for (int hi = 0; hi < 16; ++hi) acc[hi] = 0.f;
        for (int p = 0; p < 64; ++p) { const float cr = ccr[ho * 64 + p], ci = cci[ho * 64 + p], pr = pwr[j * 64 + p], pi = pwi[j * 64 + p]; const float tr = cr * pr - ci * pi, ti = cr * pi + ci * pr;
#pragma unroll
            for (int hi = 0; hi < 16; ++hi) acc[hi] += tr * bbr[p * 16 + hi] - ti * bbi[p * 16 + hi]; }
#pragma unroll
        for (int hi = 0; hi < 16; ++hi) kk[(j * 16 + ho) * 16 + hi] = acc[hi]; }
    __syncthreads();
    bf16* lt = (bf16*)(ws + WS_LT) + (size_t)g * 16 * LROW;
    for (int i = tid; i < 16 * 127 * 8; i += NTHR) { const int hp = i & 7, q = (i >> 3) % 127, ho = (i >> 3) / 127;
        unsigned w = 0u; if (q <= 63) { const LAS float* k2 = kk + ((63 - q) * 16 + ho) * 16 + 2 * hp; w = pk2(k2[0], k2[1]); }
        *(unsigned*)(lt + (size_t)ho * LROW + q * 16 + 2 * hp) = w; }
    }
    if (part != 0) {
    bf16* eg = (bf16*)(ws + WS_EG) + (size_t)g * 128 * 1024;
    for (int i = tid; i < 128 * 512; i += NTHR) { const int cp = i & 511, row = i >> 9, p = row >> 1, ri = row & 1, s = cp >> 3, hi = (cp & 7) * 2;
        const float pr = pwr[(63 - s) * 64 + p], pi = pwi[(63 - s) * 64 + p]; const float b0r = bbr[p * 16 + hi], b0i = bbi[p * 16 + hi], b1r = bbr[p * 16 + hi + 1], b1i = bbi[p * 16 + hi + 1];
        const float v0 = ri ? (pr * b0i + pi * b0r) : (pr * b0r - pi * b0i), v1 = ri ? (pr * b1i + pi * b1r) : (pr * b1r - pi * b1i);
        *(unsigned*)(eg + (size_t)row * 1024 + s * 16 + hi) = pk2(v0, v1); }
    bf16* fg = (bf16*)(ws + WS_FG) + (size_t)g * 1024 * 128;
    for (int i = tid; i < 1024 * 64; i += NTHR) { const int p = i & 63, row = i >> 6, t = row >> 4, ho = row & 15;
        const float cr = ccr[ho * 64 + p], ci = cci[ho * 64 + p], pr = pwr[(t + 1) * 64 + p], pi = pwi[(t + 1) * 64 + p];
        *(unsigned*)(fg + (size_t)row * 128 + 2 * p) = pk2(cr * pr - ci * pi, -(cr * pi + ci * pr)); }
    }
    __syncthreads();
}

__device__ __forceinline__ void conv_phase(const Frame& F, const Args& a) {
    LAS float* cw = (LAS float*)F.lds;
    const float* conv_w = a.in[14]; const int tid = opaque_tid();
    for (int i = tid; i < 3 * CONVW; i += NTHR) cw[i] = conv_w[i];
    __syncthreads();
    const bf16* pc = (const bf16*)(F.ws + WS_PC); bf16* mixed = (bf16*)(F.ws + WS_MIX);
    const int gw = F.vcu * NWAVES + F.wave, NGW = F.G * NWAVES, lane = tid & 63;
    for (int run = gw; run < M / 8; run += NGW) {
        const int r0 = run * 8; const bool hist = (r0 % SEQ) != 0;
        f32x4 h1[4][2], h2[4][2];
#pragma unroll
        for (int j = 0; j < 4; ++j) { const int c = 8 * lane + 512 * j;
            if (hist) { const bf16* p1 = pc + (size_t)(r0 - 1) * CW3, * p2 = pc + (size_t)(r0 - 2) * CW3;
                unpack8(*(const u32x4*)(p1 + CONVW + c), h1[j][0], h1[j][1]); unpack8(*(const u32x4*)(p2 + CONVW + c), h2[j][0], h2[j][1]); }
            else { h1[j][0] = h1[j][1] = h2[j][0] = h2[j][1] = (f32x4){0.f, 0.f, 0.f, 0.f}; } }
        for (int rr = 0; rr < 8; ++rr) { const bf16* pr = pc + (size_t)(r0 + rr) * CW3; f32x4 y[4][2]; float ss = 0.f;
#pragma unroll
            for (int j = 0; j < 4; ++j) { const int c = 8 * lane + 512 * j; f32x4 g0, g1, cv0, cv1;
                unpack8(*(const u32x4*)(pr + c), g0, g1); unpack8(*(const u32x4*)(pr + CONVW + c), cv0, cv1);
                const f32x4 w00 = *(const LAS f32x4*)(cw + c), w01 = *(const LAS f32x4*)(cw + c + 4), w10 = *(const LAS f32x4*)(cw + CONVW + c), w11 = *(const LAS f32x4*)(cw + CONVW + c + 4),
                            w20 = *(const LAS f32x4*)(cw + 2 * CONVW + c), w21 = *(const LAS f32x4*)(cw + 2 * CONVW + c + 4);
                y[j][0] = g0 * (w00 * h2[j][0] + w10 * h1[j][0] + w20 * cv0); y[j][1] = g1 * (w01 * h2[j][1] + w11 * h1[j][1] + w21 * cv1);
                h2[j][0] = h1[j][0]; h2[j][1] = h1[j][1]; h1[j][0] = cv0; h1[j][1] = cv1;
                ss += sumsq8(y[j][0], y[j][1]); }
            const float r = rsqrtf(wave_sum(ss) * (1.f / CONVW) + EPS);
#pragma unroll
            for (int j = 0; j < 4; ++j) { const int c = 8 * lane + 512 * j; *(u32x4*)(mixed + (size_t)(r0 + rr) * D + SSMW + c) = pack8(y[j][0] * r, y[j][1] * r); } }
    }
}

__device__ __forceinline__ void scan_group(const Frame& F, int g) {
    VM_WAIT(); __syncthreads();
    const int t = opaque_tid(); if (t >= BATCH * NP) return;
    const int p = t & 63, b = t >> 6;
    const float* a64 = (const float*)(F.ws + WS_A64) + ((size_t)g * NP + p) * 2; const float ar = a64[0], ai = a64[1];
    float* sl = (float*)(F.ws + WS_SLOC) + ((size_t)g * 256 + b * 64) * 128 + 2 * p;
    bf16* ug = (bf16*)(F.ws + WS_UG) + ((size_t)g * 256 + b * 64) * UROW + 1024 + 2 * p;
    float sr = 0.f, si = 0.f;
    for (int c0 = 0; c0 < NCH; c0 += 16) { float vr[16], vi[16];
#pragma unroll
        for (int k = 0; k < 16; ++k) { vr[k] = __hip_atomic_load(sl + (size_t)(c0 + k) * 128, RLX_AGENT); vi[k] = __hip_atomic_load(sl + (size_t)(c0 + k) * 128 + 1, RLX_AGENT); }
#pragma unroll
        for (int k = 0; k < 16; ++k) { *(unsigned*)(ug + (size_t)(c0 + k) * UROW) = pk2(sr, si);
            const float nr = ar * sr - ai * si + vr[k], ni = ar * si + ai * sr + vi[k]; sr = nr; si = ni; } }
}

#ifndef MK_PH_LO
#define MK_PH_LO 0
#endif
#ifndef MK_PH_HI
#define MK_PH_HI 99
#endif
__global__ void __launch_bounds__(NTHR, 2) mk_fwd(Args args) {
    extern __shared__ __attribute__((aligned(16))) unsigned char lds[];
    Frame F;
    F.lds = (LAS unsigned char*)lds; F.MISC = (volatile LAS unsigned*)(F.lds + MISC_OFF);
    F.wave = __builtin_amdgcn_readfirstlane((int)threadIdx.x >> 6);
    F.G = gridDim.x; { const int bx = blockIdx.x; F.vcu = (F.G % 8 == 0) ? (bx % 8) * (F.G / 8) + bx / 8 : bx; }
    F.ws = args.ws; F.out = args.out; F.ctl = (unsigned*)(args.ws + WS_CTL);
    for (int u = threadIdx.x; u < (LDS_BYTES - LDSCTL_OFF) / 4; u += NTHR) ((LAS unsigned*)(F.lds + LDSCTL_OFF))[u] = 0u;
    __syncthreads();
    XcdBarrier bar = xcd_barrier_post(F.ctl + CW_BAR, F.MISC + 8);
    unsigned char* ws = F.ws;
    float* rss_ssm = (float*)(ws + WS_CTL + CTL_ROWSS); float* rss1 = rss_ssm + M; float* rss2 = rss1 + M; float* rss3 = rss2 + M; float* rss_dummy = rss3 + M; (void)rss_dummy;
    bf16* xb = (bf16*)(ws + WS_XB);
    const int c = (int)blockIdx.x;
#ifndef MK_DUP
#define MK_DUP -1
#endif
#define RSS(k, p) (((k) == MK_DUP && _rep == 0) ? rss_dummy : (p))
#define PH(k) for (int _rep = 0; _rep < ((k) == MK_DUP ? 2 : 1); ++_rep) if ((k) >= MK_PH_LO && (k) < MK_PH_HI)

    PH(0) {
        if (F.G >= 2 * NG) { if (F.vcu < 2 * NG) ssm_tables_group(F, args, F.vcu >> 1, F.vcu & 1); }
        else if (F.vcu < NG) ssm_tables_group(F, args, F.vcu, -1);
        LAS float* scr = (LAS float*)(F.lds + F.wave * TP_TILE); const int lane0 = opaque_tid() & 63;
        const int gw = F.vcu * NWAVES + F.wave, NGW = F.G * NWAVES;
        constexpr int I_IN = (D / 64) * (PROJW / 64), I_GLU = (SSMW / 64) * (SSMW / 64), I_DD = (D / 64) * (D / 64), I_UP = (D / 64) * (2 * DFF / 64), I_DN = (DFF / 64) * (D / 64);
        constexpr int NITEMS = I_IN + 2 * I_DD;
        for (int it = gw; it < NITEMS; it += NGW) {
            int r = it;
            if (r < I_IN) { p0_transpose_item<true>(args.in[3], D, PROJW, (bf16*)(ws + WS_WIN), nullptr, scr, r, lane0); continue; } r -= I_IN;
            if (r < I_DD) { p0_transpose_item(args.in[21], D, D, (bf16*)(ws + WS_WK), nullptr, scr, r, lane0); continue; } r -= I_DD;
            p0_transpose_item(args.in[22], D, D, (bf16*)(ws + WS_WV), nullptr, scr, r, lane0);
        }
        for (int m = gw; m < M; m += NGW) rms_row_to_bf16(args.in[0] + (size_t)m * D, args.in[2], xb + (size_t)m * D, lane0, (float*)(ws + WS_CTL + CTL_XRMS) + m);
        for (int m = gw; m < D; m += NGW) cvt_row_to_bf16(args.in[20] + (size_t)m * D, args.in[18][m] * S_WQ8, (bf16*)(ws + WS_WQ + (size_t)m * D), lane0);
        for (int m = gw; m < MROWS; m += NGW) rms_row_to_bf16(args.in[1] + (size_t)m * D, args.in[19], (bf16*)(ws + WS_HM) + (size_t)m * D, lane0);
        xcd_barrier(bar);
    }
    PH(1) {
        SchedStd<D / 64, 1, D, D, 0> S; S.T.init(M / 256, PROJW / 256, F.G, c); S.A = (const char*)xb; S.B = (const char*)(ws + WS_WIN);
        EpiProj E{(bf16*)(ws + WS_UG), (bf16*)(ws + WS_PC)};
        constexpr int I_UP1 = (D / 64) * (2 * DFF / 64); const int lane1 = opaque_tid() & 63; const bool early1 = (F.vcu & 1) != 0;
        if (early1) for (int it = F.vcu * NWAVES + F.wave; it < I_UP1 / WUP_KSUB; it += F.G * NWAVES) wup_colmax_item(args.in[25], args.in[24], (float*)(ws + WS_CTL + CTL_COLMAX), it, lane1);
        gp::gemm_phase(F.lds, S, E);
        if (!early1) for (int it = F.vcu * NWAVES + F.wave; it < I_UP1 / WUP_KSUB; it += F.G * NWAVES) wup_colmax_item(args.in[25], args.in[24], (float*)(ws + WS_CTL + CTL_COLMAX), it, lane1);
        xcd_barrier(bar);
    }
    PH(2) {
        SchedP2 S{F.vcu, ws}; EpiP2 E{(float*)(ws + WS_SLOC), (bf16*)(ws + WS_KB), (bf16*)(ws + WS_VB)};
        gp::gemm_phase(F.lds, S, E);
        if (F.vcu < NG) scan_group(F, F.vcu);
        __syncthreads();
        conv_phase(F, args);
        if (F.vcu < NG) {
            __syncthreads();
            constexpr int I_GLU = (SSMW / 64) * (SSMW / 64), I_DD = (D / 64) * (D / 64);
            LAS float* scr = (LAS float*)(F.lds + F.wave * TP_TILE); const int lane0 = opaque_tid() & 63;
            for (int it = F.vcu * NWAVES + F.wave; it < I_GLU + 2 * I_DD; it += NG * NWAVES) {
                int r = it;
                if (r < I_GLU) { p0_transpose_item<false, GLU_FP8>(args.in[12], SSMW, SSMW, (bf16*)(ws + WS_GLU), nullptr, scr, r, lane0, S_GLU8); continue; } r -= I_GLU;
                if (r < I_DD) { const int kb = r / (D / 64); p0_transpose_item(args.in[17], D, D, (bf16*)(ws + WS_WOUT), (kb < 32) ? args.in[15] : args.in[16] - SSMW, scr, r, lane0); continue; } r -= I_DD;
                p0_transpose_item<false, true>(args.in[23], D, D, (bf16*)(ws + WS_WO), nullptr, scr, r, lane0, S_WO8);
            }
        }
        xcd_barrier(bar);
    }
    PH(4) {
        constexpr int I_UP4 = (D / 64) * (2 * DFF / 64); const bool early4 = (F.vcu & 1) != 0;
        if (early4) {
            LAS float* scr = (LAS float*)(F.lds + F.wave * TP_TILE); const int lane4 = opaque_tid() & 63;
            for (int it = F.vcu * NWAVES + F.wave; it < I_UP4; it += F.G * NWAVES) wup_quant_item(args.in[25], args.in[24], (const float*)(ws + WS_CTL + CTL_COLMAX), ws + WS_WUP, (float*)(ws + WS_SCB), scr, it, lane4);
            __syncthreads(); }
        { SchedAT S{F.vcu, ws}; EpiAT E{(bf16*)(ws + WS_WKB), (bf16*)(ws + WS_VWT)}; gp::gemm_phase<EpiAT, SchedAT, true, 0, true>(F.lds, S, E); }
        SchedY S{F.vcu, F.G, ws}; EpiY E{(const bf16*)(ws + WS_UG), args.in[11], (bf16*)(ws + WS_Z), ws + WS_Z8};
        gp::gemm_phase(F.lds, S, E);
        if (!early4) { VM_WAIT(); __syncthreads();
            LAS float* scr = (LAS float*)(F.lds + F.wave * TP_TILE); const int lane4 = opaque_tid() & 63;
            for (int it = F.vcu * NWAVES + F.wave; it < I_UP4; it += F.G * NWAVES) wup_quant_item(args.in[25], args.in[24], (const float*)(ws + WS_CTL + CTL_COLMAX), ws + WS_WUP, (float*)(ws + WS_SCB), scr, it, lane4); }
        xcd_barrier(bar);
    }
    PH(5) {
        EpiGlu E{(const bf16*)(ws + WS_Z), args.in[13], (bf16*)(ws + WS_MIX), RSS(5, rss_ssm)};
        if constexpr (GLU_FP8) { SchedStd<SSMW / 128, 1, SSMW / 2, SSMW / 2, 0> S; S.T.init(M / 256, SSMW / 256, F.G, c); S.A = (const char*)(ws + WS_Z8); S.B = (const char*)(ws + WS_GLU);
            gp::gemm_phase<EpiGlu, decltype(S), true, 0, true>(F.lds, S, E); }
        else { SchedStd<SSMW / 64, 1, SSMW, SSMW, 0> S; S.T.init(M / 256, SSMW / 256, F.G, c); S.A = (const char*)(ws + WS_Z); S.B = (const char*)(ws + WS_GLU);
            gp::gemm_phase(F.lds, S, E); }
        xcd_barrier(bar);
    }
    PH(6) {
        SchedStd<SSMW / 64, 2, D, D, gp::F_MID> S; S.T.init(M / 256, D / 256, F.G, c); S.A = (const char*)(ws + WS_MIX); S.B = (const char*)(ws + WS_WOUT);
        EpiRes<true, true> E{args.in[2], xb, RSS(6, rss1), rss_ssm, ws + WS_X8, nullptr, (const float*)(ws + WS_CTL + CTL_XRMS)};
        gp::gemm_phase(F.lds, S, E);
        xcd_barrier(bar);
    }
    PH(8) {
        SchedS S{F.vcu, ws}; EpiSoftmax E{(bf16*)(ws + WS_P), rss1};
        gp::gemm_phase<EpiSoftmax, SchedS, true, 0, true>(F.lds, S, E);
        xcd_barrier(bar);
    }
    PH(10) {
        SchedAO S; S.T.init(M / 256, D / 256, F.G, c); S.ws = ws;
        EpiRes<false, false, true> E{nullptr, xb, rss2, nullptr, nullptr, ws + WS_A8, rss1};
        gp::gemm_phase<EpiRes<false, false, true>, SchedAO, true, 0, true>(F.lds, S, E);
        xcd_barrier(bar);
    }
    PH(11) {
        SchedStd<D / 128, 1, D / 2, D / 2, 0, true> S; S.T.init(M / 256, 2 * DFF / 256, F.G, c); S.A = (const char*)(ws + WS_A8); S.B = (const char*)(ws + WS_WUP);
        EpiFfn E{rss2, (bf16*)(ws + WS_ACT), (float*)(ws + WS_HALO), args.in[26], args.in[27], F.lds, rss1, (const float*)(ws + WS_SCB)};
        gp::gemm_phase<EpiFfn, decltype(S), true, 0, false, true>(F.lds, S, E);
        {
            constexpr int I_DN = (DFF / 64) * (D / 64); const int half = F.G / 2, cc = c - half;
            if (cc >= 0) { __syncthreads(); LAS float* scr = (LAS float*)(F.lds + F.wave * TP_TILE); const int lane0 = opaque_tid() & 63;
                for (int it = cc * NWAVES + F.wave; it < I_DN; it += half * NWAVES) p0_transpose_item(args.in[28], DFF, D, (bf16*)(ws + WS_WDN), nullptr, scr, it, lane0); }
        }
        xcd_barrier(bar);
    }
    PH(13) {
        SchedStd<DFF / 64, 1, DFF, DFF, 0> S; S.T.init(M / 256, D / 256, F.G, c, 4);     S.A = (const char*)(ws + WS_ACT) + (DFF / 64 - 1) * 128; S.B = (const char*)(ws + WS_WDN) + (DFF / 64 - 1) * 128;
        { int pm0, pn0, pm1, pn1, i1 = 0; bool same = S.T.tile(0, pm0, pn0);
          while (S.T.tile(++i1, pm1, pn1)) same = same && (pm1 == pm0);
          if (S.T.tile(0, pm0, pn0)) { if (same) ffn_fixup_tile(F, args, pm0); else { int pmd = -1; for (int i2 = 0; S.T.tile(i2, pm1, pn1); ++i2) { if (pm1 != pmd) ffn_fixup_tile(F, args, pm1); pmd = pm1; } }     }
          VM_WAIT(); __syncthreads(); }
#if MK_DUP == 131
        { SchedQuarter<DFF / 64, DFF, DFF> S0{c, (const char*)(ws + WS_ACT), (const char*)(ws + WS_WDN)}; EpiNull E0{rss_dummy}; gp::gemm_phase(F.lds, S0, E0); xcd_barrier(bar); }
#endif
#if MK_DUP == 132
        { EpiNull E0{rss_dummy}; gp::gemm_phase(F.lds, S, E0); xcd_barrier(bar); }
#endif
        EpiRes<false, false> E{nullptr, xb, RSS(13, rss3), nullptr, nullptr, nullptr, nullptr};
        gp::gemm_phase<EpiRes<false, false>, decltype(S), true, 0, false, false, true>(F.lds, S, E);
        xcd_barrier(bar);
    }
    PH(14) {
        const int gw = F.vcu * NWAVES + F.wave, NGW = F.G * NWAVES, lane14 = opaque_tid() & 63; const float* gf = args.in[29];
        for (int m = gw; m < M; m += NGW) { const float r = rsqrtf(__hip_atomic_load(rss3 + m, RLX_AGENT) * (1.f / D) + EPS);
            const u32x4* xr = (const u32x4*)(xb + (size_t)m * D) + lane14; f32x4* orow = (f32x4*)(F.out + (size_t)m * D) + 2 * lane14;
            u32x4 v[8];
#pragma unroll
            for (int j = 0; j < 8; ++j) v[j] = xr[64 * j];
#pragma unroll
            for (int j = 0; j < 8; ++j) { f32x4 a, b; unpack8(v[j], a, b); const f32x4 g0 = *(const f32x4*)(gf + 512 * j + 8 * lane14), g1 = *(const f32x4*)(gf + 512 * j + 8 * lane14 + 4);
                orow[128 * j] = a * g0 * r; orow[128 * j + 1] = b * g1 * r; } }
    }
#undef PH
}

extern "C" void kernel_launch(void* const* d_in, const int* in_sizes, int n_in, void* d_out, int out_size, void* d_ws, size_t ws_size, hipStream_t stream) {
    static int grid = 0;
    if (grid == 0) {
        if (n_in != 30 || in_sizes[0] != M * D || out_size != M * D || ws_size < WS_END) { fprintf(stderr, "kernel_launch: unexpected shapes (n_in %d, out %d, ws %zu, need %zu); nothing launched\n", n_in, out_size, ws_size, (size_t)WS_END); grid = -1; return; }
        int dev = 0, cus = 0, per_cu = 0;
        if (hipGetDevice(&dev) != hipSuccess || hipDeviceGetAttribute(&cus, hipDeviceAttributeMultiprocessorCount, dev) != hipSuccess) { grid = -1; return; }
        if (hipFuncSetAttribute((const void*)mk_fwd, hipFuncAttributeMaxDynamicSharedMemorySize, LDS_BYTES) != hipSuccess) { fprintf(stderr, "kernel_launch: hipFuncSetAttribute failed\n"); grid = -1; return; }
        if (hipOccupancyMaxActiveBlocksPerMultiprocessor(&per_cu, (const void*)mk_fwd, NTHR, LDS_BYTES) != hipSuccess || per_cu < 1) { fprintf(stderr, "kernel_launch: occupancy query says %d\n", per_cu); }
        (void)hipGetLastError();
        grid = cus;
    }
    if (grid < 0) return;
    if (hipMemsetAsync((char*)d_ws + WS_CTL, 0, CTL_ZERO_BYTES, stream) != hipSuccess) return;
    Args a{};
    for (int i = 0; i < 30; ++i) a.in[i] = (const float*)d_in[i];
    a.out = (float*)d_out; a.ws = (unsigned char*)d_ws;
    hipLaunchKernelGGL(mk_fwd, dim3(grid), dim3(NTHR), LDS_BYTES, stream, a);
}
```

```cpp
#include <hip/hip_runtime.h>
#include <cstdio>
#include <cstdint>

#define GAS __attribute__((address_space(1)))
#define LAS __attribute__((address_space(3)))
typedef unsigned short bf16;
typedef short bf16x8 __attribute__((ext_vector_type(8)));
typedef float f32x4 __attribute__((ext_vector_type(4)));
typedef float f32x2 __attribute__((ext_vector_type(2)));
typedef unsigned u32x4 __attribute__((ext_vector_type(4)));
typedef unsigned u32x2 __attribute__((ext_vector_type(2)));
typedef int i32x4 __attribute__((ext_vector_type(4)));
typedef int i32x8 __attribute__((ext_vector_type(8)));

constexpr int D = 4096, BATCH = 4, SEQ = 4096, M = BATCH * SEQ, NMEM = 256, MROWS = BATCH * NMEM;
constexpr int SSMW = 2048, CONVW = 2048, NG = 128, GH = 16, NP = 64, DFF = 11008, PROJW = 8192, NH = 4, HD = 1024, CW3 = 4096;
constexpr int TCH = 64, NCH = SEQ / TCH;
constexpr int UROW = 1152;
constexpr int LROW = 127 * 16;
constexpr float EPS = 1e-6f;
constexpr int NWAVES = 8, NTHR = 512;

constexpr size_t MiB = 1u << 20;
constexpr size_t WS_CTL = 0, CTL_ZERO_BYTES = 1 * MiB;
constexpr size_t CTL_ROWSS = 256 * 1024;
constexpr size_t CTL_XRMS = 832 * 1024;
constexpr size_t CTL_COLMAX = 640 * 1024;
constexpr size_t WS_WIN = 2 * MiB;
constexpr size_t WS_GLU = WS_WIN + 64 * MiB;
constexpr size_t WS_WOUT = WS_GLU + 8 * MiB;
constexpr size_t WS_WQ = WS_WOUT + 32 * MiB, WS_WK = WS_WQ + 32 * MiB, WS_WV = WS_WK + 32 * MiB, WS_WO = WS_WV + 32 * MiB;
constexpr size_t WS_WUP = WS_WO + 32 * MiB;
constexpr size_t WS_WDN = WS_WUP + 172 * MiB;
constexpr size_t WS_XB = WS_WDN + 86 * MiB;
constexpr size_t WS_HM = WS_XB + 128 * MiB;
constexpr size_t WS_KB = WS_HM + 8 * MiB;
constexpr size_t WS_VB = WS_KB + 8 * MiB;
constexpr size_t WS_A64 = WS_VB + 8 * MiB;
constexpr size_t WS_R = WS_A64 + 1 * MiB;
constexpr size_t WS_ACT = WS_R;
constexpr size_t WS_HALO = WS_ACT + 344 * MiB;
constexpr size_t WS_UG = WS_R;
constexpr size_t WS_PC = WS_UG + 72 * MiB;
constexpr size_t WS_Z8 = WS_PC + 64 * MiB;
constexpr size_t WS_SCB = WS_A64 + 512 * 1024;
constexpr size_t WS_A8 = WS_R + 520 * MiB;
constexpr float QCLIP = 4.2f, QCLIPW = 4.0f;
constexpr size_t WS_X8 = WS_UG;
constexpr size_t WS_WKB = WS_PC;
constexpr size_t WS_VWT = WS_PC + 32 * MiB;
constexpr size_t WS_Z = WS_PC + 192 * MiB;
constexpr size_t WS_MIX = WS_Z + 64 * MiB;
constexpr size_t WS_P = WS_MIX + 128 * MiB;
constexpr size_t WS_LT = WS_P + 32 * MiB;
constexpr size_t WS_EG = WS_LT + 8 * MiB;
constexpr size_t WS_FG = WS_EG + 32 * MiB;
constexpr size_t WS_SLOC = WS_FG + 32 * MiB;
constexpr size_t WS_END = WS_R + 688 * MiB;
static_assert(WS_HALO + 17 * MiB <= WS_A8 && WS_A8 + 64 * MiB <= WS_END, "halo / a8 fit");
static_assert(WS_SLOC + 16 * MiB <= WS_END, "overlay fits");
constexpr int CW_BAR = 4096;

constexpr int EX_OFF = 135168;
constexpr int RING_BYTES = 131072, TP_TILE = 64 * 65 * 4  , LDSCTL_OFF = 8 * TP_TILE, MISC_OFF = LDSCTL_OFF + 320, LDS_BYTES = 147456;
static_assert(LDSCTL_OFF >= RING_BYTES && MISC_OFF + 128 <= LDS_BYTES, "LDS map");

#define RLX_AGENT __ATOMIC_RELAXED, __HIP_MEMORY_SCOPE_AGENT
#define LDS_WAIT() asm volatile("s_waitcnt lgkmcnt(0)" ::: "memory")
#define VM_WAIT() asm volatile("s_waitcnt vmcnt(0)" ::: "memory")
__device__ __forceinline__ unsigned f2bf(float f) { unsigned u = __builtin_bit_cast(unsigned, f); return (u + 0x7fffu + ((u >> 16) & 1u)) >> 16; }
__device__ __forceinline__ unsigned pk2(float lo, float hi) { return f2bf(lo) | (f2bf(hi) << 16); }
__device__ __forceinline__ float bflo(unsigned w) { return __builtin_bit_cast(float, w << 16); }
__device__ __forceinline__ float bfhi(unsigned w) { return __builtin_bit_cast(float, w & 0xffff0000u); }
__device__ __forceinline__ unsigned cvt_pk_bf16(float lo, float hi) { unsigned r; asm volatile("v_cvt_pk_bf16_f32 %0, %1, %2" : "=v"(r) : "v"(lo), "v"(hi)); return r; }
__device__ __forceinline__ float wave_sum(float v) {
#pragma unroll
    for (int o = 1; o < 64; o <<= 1) v += __shfl_xor(v, o);
    return v;
}
__device__ __forceinline__ int opaque_tid() { int t = threadIdx.x; asm volatile("" : "+v"(t)); return t; }
__device__ __forceinline__ float fast_sigmoid(float x) { return __builtin_amdgcn_rcpf(1.f + __expf(-x)); }
__device__ __forceinline__ f32x4 fast_sigmoid4(const f32x4& x) {
    const f32x4 t = x * -1.4426950408889634f;
    const f32x4 d = (f32x4){__builtin_amdgcn_exp2f(t[0]), __builtin_amdgcn_exp2f(t[1]), __builtin_amdgcn_exp2f(t[2]), __builtin_amdgcn_exp2f(t[3])} + 1.f;
    return (f32x4){__builtin_amdgcn_rcpf(d[0]), __builtin_amdgcn_rcpf(d[1]), __builtin_amdgcn_rcpf(d[2]), __builtin_amdgcn_rcpf(d[3])};
}
__device__ __forceinline__ float gelu_tanh(float x) { return x * fast_sigmoid(1.5957691216057308f * (x + 0.044715f * x * x * x)); }

#define XB_TMO      128
#define XB_XCNT(j)  (256  + 64 * (j))
#define XB_XSUB(j)  (1280 + 64 * (j))
#define XB_XGEN(j)  (2304 + 64 * (j))
#define XB_TOP      3328
#define XB_TOPGEN   3392
#define XCD_BAR_WORDS 3456
#define XB_SPIN_CAP (1u << 22)
__device__ __forceinline__ unsigned xb_ld(unsigned* p)              { return __hip_atomic_load(p, __ATOMIC_RELAXED, __HIP_MEMORY_SCOPE_AGENT); }
__device__ __forceinline__ unsigned xb_add(unsigned* p, unsigned v) { return __hip_atomic_fetch_add(p, v, __ATOMIC_RELAXED, __HIP_MEMORY_SCOPE_AGENT); }
__device__ __forceinline__ unsigned xb_xcc_id() { return (unsigned)__builtin_amdgcn_s_getreg((3 << 11) | 20) & 0xFu; }
#define XB_SPIN(cond, bar) do { unsigned _sp = 0; while (cond) { __builtin_amdgcn_s_sleep(1); \
    if ((++_sp & 255u) == 0u) { if (xb_ld(&(bar)[XB_TMO])) break; if (_sp > XB_SPIN_CAP) { atomicAdd(&(bar)[XB_TMO], 1u); break; } } } } while (0)
struct XcdBarrier { unsigned* bar; unsigned x; volatile LAS unsigned* st; };
__device__ __forceinline__ XcdBarrier xcd_barrier_post(unsigned* bar, volatile LAS unsigned* st) {
    XcdBarrier b; b.bar = bar; b.x = xb_xcc_id(); b.st = st;
    if (threadIdx.x == 0) (void)xb_add(&bar[XB_XCNT(b.x)], 1u);
    return b;
}
__device__ __forceinline__ void xcd_barrier_complete(unsigned* bar, unsigned x, unsigned& nloc, unsigned& nx) {
    const unsigned G = gridDim.x * gridDim.y * gridDim.z;
    unsigned sum, cnt, mine, sp = 0u;
    for (;;) {
        sum = 0u; cnt = 0u; mine = 0u;
#pragma unroll
        for (unsigned j = 0; j < 16; ++j) { const unsigned c = xb_ld(&bar[XB_XCNT(j)]); sum += c; cnt += (c > 0u) ? 1u : 0u; mine = (j == x) ? c : mine; }
        if (sum == G) break;
        __builtin_amdgcn_s_sleep(1);
        if ((++sp & 255u) == 0u) { if (xb_ld(&bar[XB_TMO])) break; if (sp > XB_SPIN_CAP) { atomicAdd(&bar[XB_TMO], 1u); break; } }
    }
    nloc = mine > 0u ? mine : 1u; nx = cnt > 0u ? cnt : 1u;
}
__device__ __forceinline__ void xcd_barrier(const XcdBarrier& b) {
    asm volatile("s_waitcnt vmcnt(0)" ::: "memory");
    __syncthreads();
    if (threadIdx.x == 0) {
        unsigned* bar = b.bar;
        __builtin_amdgcn_s_waitcnt(0);
        unsigned nloc = b.st[0], nx = b.st[1];
        if (nloc == 0u) { xcd_barrier_complete(bar, b.x, nloc, nx); b.st[0] = nloc; b.st[1] = nx; }
        const unsigned old = xb_add(&bar[XB_XSUB(b.x)], 1u);
        const unsigned gen = old / nloc;
        if (old + 1u == (gen + 1u) * nloc) {
            __builtin_amdgcn_fence(__ATOMIC_RELEASE, "agent");
            asm volatile("s_waitcnt vmcnt(0)" ::: "memory");
            const unsigned og = xb_add(&bar[XB_TOP], 1u);
            const unsigned tg = og / nx;
            if (og + 1u == (tg + 1u) * nx) xb_add(&bar[XB_TOPGEN], 1u);
            else XB_SPIN(xb_ld(&bar[XB_TOPGEN]) == tg, bar);
            __builtin_amdgcn_fence(__ATOMIC_ACQUIRE, "agent");
            xb_add(&bar[XB_XGEN(b.x)], 1u);
            asm volatile("s_waitcnt vmcnt(0)" ::: "memory");
        } else {
            XB_SPIN(xb_ld(&bar[XB_XGEN(b.x)]) == gen, bar);
            __builtin_amdgcn_fence(__ATOMIC_ACQUIRE, "agent");
            asm volatile("s_waitcnt vmcnt(0)" ::: "memory");
        }
    }
    __syncthreads();
}

namespace gp {
constexpr int BM = 256, BK = 64, HALF = 128, HTB = HALF * BK * 2, STAGE_BYTES = 8 * HTB, NXCD = 8, WGM = 8;
__device__ __forceinline__ int lds_byte(int r, int c) { const int st = (r >> 4) * 2 + (c >> 5), rr = r & 15, cc = c & 31, ob = rr * 64 + cc * 2; return st * 1024 + (ob ^ (((ob >> 9) & 1) << 5)); }
__device__ __forceinline__ void stage_rc(int b, int& R, int& C) { const int st = b / 1024, sb = b % 1024, swz = sb ^ (((sb >> 9) & 1) << 5); R = (st >> 1) * 16 + swz / 64; C = (st & 1) * 32 + (swz % 64) / 2; }
__device__ __forceinline__ int perm32(int rho) { const int n = rho >> 4, i = rho & 15; return 8 * (i >> 2) + 4 * n + (i & 3); }

enum { BT_STD = 0, BT_ALIAS = 1, BT_TOEP = 2 };
enum { F_FIRST = 1, F_LAST = 2, F_MID = 4 };
struct Seg { const char* A; const char* B; int nt, flags, u0, u1; };

template <bool AROWPERM = false>
__device__ __forceinline__ void set_layout(int lda, int ldb, int bt, int tid, unsigned (&voffA)[2], unsigned (&voffB)[2], long& hsA, long& hsB) {
#pragma unroll
    for (int i = 0; i < 2; ++i) { int R, C; stage_rc(tid * 16 + i * 8192, R, C); const int Rb = (R & ~31) + perm32(R & 31);
        const int Ra = AROWPERM ? ((R & ~63) + 4 * (R & 15) + ((R >> 4) & 3)) : R;
        voffA[i] = (unsigned)(Ra * lda + C) * 2u;
        voffB[i] = (bt == BT_TOEP) ? (unsigned)((Rb & 15) * (LROW * 2) + (7 - (Rb >> 4)) * 32 + C * 2) : (unsigned)(Rb * ldb + C) * 2u; }
    hsA = (long)HALF * lda * 2;
    hsB = (bt == BT_STD) ? (long)HALF * ldb * 2 : (bt == BT_ALIAS ? 0l : -256l);
}

template <class Epi, class Sched, bool SP2 = true, int PROBE = 0, bool FP8 = false, bool I8 = false, bool KREV = false>
__device__ __forceinline__ void gemm_phase(LAS unsigned char* lds, const Sched& S, const Epi& E) {
    int tid_ = threadIdx.x; asm volatile("" : "+v"(tid_));
    const int tid = tid_, wid = __builtin_amdgcn_readfirstlane(tid >> 6), lane = tid & 63, wr = wid >> 2, wc = wid & 3, fr = lane & 15, fq = lane >> 4;
    Seg cur, nxt; int si = 0;
    if (!S.next(0, cur)) return;
    unsigned voffA[2], voffB[2]; long hsA, hsB;
    S.layout(cur, tid, voffA, voffB, hsA, hsB);
    const unsigned ldsw = (unsigned)wid * 1024u;
    const unsigned ldsbase = (unsigned)__builtin_amdgcn_readfirstlane((int)(unsigned)(__UINTPTR_TYPE__)lds);
    const int aoff = lds_byte(wr * 64 + fr, fq * 8), boff = lds_byte(wc * 32 + fr, fq * 8);
#define G_SA(b, h) (((b) * 2 + (h)) * HTB)
#define G_SB(b, h) ((4 + (b) * 2 + (h)) * HTB)
#define G_STAGE(bufoff, gbase, voff) do { if constexpr (PROBE == 0) _Pragma("unroll") for (int _i = 0; _i < 2; ++_i) \
        { const unsigned _l = ldsbase + (unsigned)(bufoff) + ldsw + (unsigned)_i * 8192u; \
          asm volatile("s_mov_b32 m0, %2\n\ts_nop 0\n\tglobal_load_lds_dwordx4 %0, %1" :: "v"((voff)[_i]), "s"((const char*)(gbase)), "s"(_l) : "memory"); } } while (0)
#define G_CAT8(x0, x1) __builtin_shufflevector(__builtin_bit_cast(i32x4, x0), __builtin_bit_cast(i32x4, x1), 0, 1, 2, 3, 4, 5, 6, 7)
#define G_LDA(dst, b, h) do { if constexpr (FP8) { _Pragma("unroll") for (int m = 0; m < 4; ++m) dst##8[m] = G_CAT8(*(const LAS bf16x8*)(lds + G_SA(b, h) + aoff + m * 2048), *(const LAS bf16x8*)(lds + G_SA(b, h) + aoff + m * 2048 + 1024)); } \
        else if constexpr (PROBE < 2) _Pragma("unroll") for (int m = 0; m < 4; ++m) _Pragma("unroll") for (int k = 0; k < 2; ++k) dst[m][k] = *(const LAS bf16x8*)(lds + G_SA(b, h) + aoff + m * 2048 + k * 1024); } while (0)
#define G_LDB(dst, b, h) do { if constexpr (FP8) { _Pragma("unroll") for (int n = 0; n < 2; ++n) dst##8[n] = G_CAT8(*(const LAS bf16x8*)(lds + G_SB(b, h) + boff + n * 2048), *(const LAS bf16x8*)(lds + G_SB(b, h) + boff + n * 2048 + 1024)); } \
        else if constexpr (PROBE < 2) _Pragma("unroll") for (int n = 0; n < 2; ++n) _Pragma("unroll") for (int k = 0; k < 2; ++k) dst[n][k] = *(const LAS bf16x8*)(lds + G_SB(b, h) + boff + n * 2048 + k * 1024); } while (0)
#define G_MMA(ai, bj, At, Bt) do { __builtin_amdgcn_s_setprio(1); \
        if constexpr (FP8) { _Pragma("unroll") for (int m = 0; m < 4; ++m) _Pragma("unroll") for (int n = 0; n < 2; ++n) \
            asm volatile("v_mfma_scale_f32_16x16x128_f8f6f4 %0, %1, %2, %0, %3, %3 op_sel_hi:[0,0,0]" : "+v"(acc[ai][bj][m][n]) : "v"(Bt##8[n]), "v"(At##8[m]), "v"(fp8_unit_scale)); } \
        else if constexpr (I8) { _Pragma("unroll") for (int k = 0; k < 2; ++k) _Pragma("unroll") for (int m = 0; m < 4; ++m) _Pragma("unroll") for (int n = 0; n < 2; ++n) \
            asm volatile("v_mfma_i32_16x16x64_i8 %0, %1, %2, %0" : "+v"(acc[ai][bj][m][n]) : "v"(Bt[n][k]), "v"(At[m][k])); } \
        else { _Pragma("unroll") for (int m = 0; m < 4; ++m) _Pragma("unroll") for (int n = 0; n < 2; ++n) _Pragma("unroll") for (int k = 0; k < 2; ++k) \
            acc[ai][bj][m][n] = __builtin_amdgcn_mfma_f32_16x16x32_bf16(Bt[n][k], At[m][k], acc[ai][bj][m][n], 0, 0, 0); } \
        __builtin_amdgcn_s_setprio(0); } while (0)
#define G_WAIT_V(n) asm volatile("s_waitcnt vmcnt(" #n ")" ::: "memory")
#define G_WAIT_L(n) asm volatile("s_waitcnt lgkmcnt(" #n ")" ::: "memory")
#define G_BAR do { if constexpr (PROBE < 3) __builtin_amdgcn_s_barrier(); } while (0)
#define G_SCHED __builtin_amdgcn_sched_barrier(0)
    f32x4 acc[2][2][4][2];
#pragma unroll
    for (int a = 0; a < 2; ++a)
#pragma unroll
        for (int b = 0; b < 2; ++b)
#pragma unroll
            for (int m = 0; m < 4; ++m)
#pragma unroll
                for (int n = 0; n < 2; ++n) acc[a][b][m][n] = (f32x4){0.f, 0.f, 0.f, 0.f};
    const int fp8_unit_scale = 0x7f7f7f7f;
    bf16x8 At[4][2], B0[2][2], B1[2][2]; i32x8 At8[4], B08[2], B18[2];
    if constexpr (PROBE >= 2) {
#pragma unroll
        for (int m = 0; m < 4; ++m)
#pragma unroll
            for (int k = 0; k < 2; ++k) { At[m][k] = (bf16x8){(short)(0x3c00 + tid), 1, 2, 3, 4, 5, 6, 7}; asm volatile("" : "+v"(At[m][k])); }
#pragma unroll
        for (int n = 0; n < 2; ++n)
#pragma unroll
            for (int k = 0; k < 2; ++k) { B0[n][k] = (bf16x8){(short)(0x3c10 + tid), 1, 2, 3, 4, 5, 6, 7}; B1[n][k] = B0[n][k]; asm volatile("" : "+v"(B0[n][k]), "+v"(B1[n][k])); }
    }
    const char* cA = cur.A; const char* cB = cur.B;
    constexpr long kstep = KREV ? -(long)(BK * 2) : (long)(BK * 2);
    if constexpr (SP2) {
    G_STAGE(G_SB(0, 0), cB, voffB); G_STAGE(G_SB(0, 1), cB + hsB, voffB); G_STAGE(G_SA(0, 0), cA, voffA); G_STAGE(G_SA(0, 1), cA + hsA, voffA);
    if (wr == 1) G_BAR;
    G_WAIT_V(2); G_BAR;
    G_STAGE(G_SB(1, 0), cB + kstep, voffB); G_STAGE(G_SA(1, 0), cA + kstep, voffA); G_STAGE(G_SB(1, 1), cB + hsB + kstep, voffB);
    G_WAIT_V(6); G_BAR;
    } else {
    G_STAGE(G_SB(0, 0), cB, voffB); G_STAGE(G_SA(0, 0), cA, voffA); G_STAGE(G_SB(0, 1), cB + hsB, voffB); G_STAGE(G_SA(0, 1), cA + hsA, voffA);
    if (wr == 1) G_BAR;
    G_WAIT_V(4); G_BAR;
    G_STAGE(G_SB(1, 0), cB + kstep, voffB); G_STAGE(G_SA(1, 0), cA + kstep, voffA); G_STAGE(G_SB(1, 1), cB + hsB + kstep, voffB);
    G_WAIT_V(6); G_BAR;
    }
    for (;;) {
        const bool has_next = S.next(si + 1, nxt);
        const char* nA = has_next ? nxt.A : cA; const char* nB = has_next ? nxt.B : cB;
        const int nt = (Sched::FIXED_NT > 0) ? Sched::FIXED_NT : cur.nt;
#pragma nounroll
        for (int t = 0; t < nt; t += 2) {
            const bool last = (t == nt - 2);
            const char* a1 = cA + (long)(t + 1) * kstep;
            if constexpr (SP2) {
            G_LDB(B0, 0, 0); G_LDB(B1, 0, 1); G_SCHED; G_LDA(At, 0, 0); G_STAGE(G_SA(1, 1), a1 + hsA, voffA);
            if constexpr (Sched::LAYOUT_CHANGES) { if (last && has_next) S.layout(nxt, tid, voffA, voffB, hsA, hsB); }
            const char* a2 = last ? nA : cA + (long)(t + 2) * kstep; const char* b2 = last ? nB : cB + (long)(t + 2) * kstep;
            const char* a3 = a2 + kstep; const char* b3 = b2 + kstep;
            G_WAIT_V(8); G_WAIT_L(0); G_BAR; G_MMA(0, 0, At, B0); G_MMA(0, 1, At, B1); G_BAR; G_SCHED;
            G_LDA(At, 0, 1); G_STAGE(G_SB(0, 0), b2, voffB); G_STAGE(G_SB(0, 1), b2 + hsB, voffB); G_STAGE(G_SA(0, 0), a2, voffA);
            G_WAIT_V(8); G_WAIT_L(0); G_BAR; G_MMA(1, 0, At, B0); G_MMA(1, 1, At, B1); G_BAR; G_SCHED;
            G_LDB(B0, 1, 0); G_LDB(B1, 1, 1); G_SCHED; G_LDA(At, 1, 0); G_STAGE(G_SA(0, 1), a2 + hsA, voffA);
            G_WAIT_V(8); G_WAIT_L(0); G_BAR; G_MMA(0, 0, At, B0); G_MMA(0, 1, At, B1); G_BAR; G_SCHED;
            G_LDA(At, 1, 1); G_STAGE(G_SB(1, 0), b3, voffB); G_STAGE(G_SB(1, 1), b3 + hsB, voffB); G_STAGE(G_SA(1, 0), a3, voffA);
            G_WAIT_V(8); G_WAIT_L(0); G_BAR; G_MMA(1, 0, At, B0); G_MMA(1, 1, At, B1); G_BAR; G_SCHED;
                    } else {
            G_LDB(B0, 0, 0); G_SCHED; G_LDA(At, 0, 0); G_STAGE(G_SA(1, 1), a1 + hsA, voffA);
            if constexpr (Sched::LAYOUT_CHANGES) { if (last && has_next) S.layout(nxt, tid, voffA, voffB, hsA, hsB); }
            const char* a2 = last ? nA : cA + (long)(t + 2) * kstep; const char* b2 = last ? nB : cB + (long)(t + 2) * kstep;
            const char* a3 = a2 + kstep; const char* b3 = b2 + kstep;
            G_WAIT_L(8); G_BAR; G_WAIT_L(0); G_MMA(0, 0, At, B0); G_BAR; G_SCHED;
            G_LDB(B1, 0, 1); G_STAGE(G_SB(0, 0), b2, voffB);
            G_BAR; G_WAIT_L(0); G_MMA(0, 1, At, B1); G_BAR;
            G_LDA(At, 0, 1); G_STAGE(G_SA(0, 0), a2, voffA);
            G_BAR; G_WAIT_L(0); G_MMA(1, 0, At, B0); G_BAR; G_SCHED;
            G_STAGE(G_SB(0, 1), b2 + hsB, voffB);
            G_WAIT_V(6); G_BAR; G_MMA(1, 1, At, B1); G_BAR;
            G_LDB(B0, 1, 0); G_SCHED; G_LDA(At, 1, 0); G_STAGE(G_SA(0, 1), a2 + hsA, voffA);
            G_WAIT_L(8); G_BAR; G_WAIT_L(0); G_MMA(0, 0, At, B0); G_BAR; G_SCHED;
            G_LDB(B1, 1, 1); G_STAGE(G_SB(1, 0), b3, voffB);
            G_BAR; G_WAIT_L(0); G_MMA(0, 1, At, B1); G_BAR;
            G_LDA(At, 1, 1); G_STAGE(G_SA(1, 0), a3, voffA);
            G_BAR; G_WAIT_L(0); G_MMA(1, 0, At, B0); G_BAR; G_SCHED;
            G_STAGE(G_SB(1, 1), b3 + hsB, voffB);
            G_WAIT_V(6); G_BAR; G_MMA(1, 1, At, B1); G_BAR;
            }
        }
        if constexpr (FP8 || I8) asm volatile("s_nop 15\n\ts_nop 15" ::: "memory");
        const bool unit_end = (cur.flags & F_LAST) != 0;
        if constexpr (Epi::HAS_MID) E.mid(acc, cur, wr, wc, fr, fq);
        if (unit_end) {
            if (wr == 0) G_BAR;
            if constexpr (!Epi::AFTER_DRAIN) E(acc, cur, wr, wc, fr, fq);
        }
        if (!has_next) break;
        if (unit_end) {
#pragma unroll
            for (int a = 0; a < 2; ++a)
#pragma unroll
                for (int b = 0; b < 2; ++b)
#pragma unroll
                    for (int m = 0; m < 4; ++m)
#pragma unroll
                        for (int n = 0; n < 2; ++n) acc[a][b][m][n] = (f32x4){0.f, 0.f, 0.f, 0.f};
        }
        cur = nxt; cA = nA; cB = nB; ++si;
        if (unit_end) { if (wr == 1) G_BAR; }
    }
    G_WAIT_V(0);
    G_BAR;
    if constexpr (Epi::AFTER_DRAIN) E.fused(acc, cur, wr, wc, fr, fq, lds, wid, lane);
#undef G_SA
#undef G_SB
#undef G_STAGE
#undef G_LDA
#undef G_LDB
#undef G_MMA
#undef G_CAT8
#undef G_WAIT_V
#undef G_WAIT_L
#undef G_BAR
#undef G_SCHED
}

struct TileOrder {
    int nM, nN, nwg, G, c, wgm;
    __device__ __forceinline__ void init(int nM_, int nN_, int G_, int c_, int wgm_ = WGM) { nM = nM_; nN = nN_; nwg = nM * nN; G = G_; c = c_; wgm = wgm_; }
    __device__ __forceinline__ bool tile(int i, int& pm, int& pn) const {
        const long L = (long)i * G + c; if (L >= nwg) return false;
        int wgid = (int)L; { const int q = nwg / NXCD, r = nwg % NXCD, xcd = wgid % NXCD, off = wgid / NXCD; wgid = (xcd < r ? xcd * (q + 1) : r * (q + 1) + (xcd - r) * q) + off; }
        const int nig = wgm * nN, gid = wgid / nig, fm = gid * wgm, gsz = (nM - fm) < wgm ? (nM - fm) : wgm;
        pm = fm + ((wgid % nig) % gsz); pn = (wgid % nig) / gsz; return true;
    }
};
}

struct Args {
    const float* in[30]; float* out; unsigned char* ws;
};
struct Frame {
    LAS unsigned char* lds; volatile LAS unsigned* MISC; unsigned* ctl;
    int wave, vcu, G;
    unsigned char* ws; float* out;
};

template <int NTSEG, int NSEG, int LDA, int LDB, int MIDFLAG, bool AROWPERM = false> struct SchedStd {
    static constexpr bool LAYOUT_CHANGES = false; static constexpr int FIXED_NT = NTSEG;
    gp::TileOrder T; const char* A; const char* B;
    __device__ __forceinline__ bool next(int i, gp::Seg& s) const {
        const int ui = i / NSEG, sg = i - ui * NSEG; int pm, pn; if (!T.tile(ui, pm, pn)) return false;
        s.A = A + ((size_t)pm * 256 * LDA + (size_t)sg * NTSEG * 64) * 2; s.B = B + ((size_t)pn * 256 * LDB + (size_t)sg * NTSEG * 64) * 2;
        s.nt = NTSEG;
        s.flags = (sg == 0 ? gp::F_FIRST : 0) | (sg == NSEG - 1 ? gp::F_LAST : MIDFLAG); s.u0 = pm; s.u1 = pn; return true;
    }
    __device__ __forceinline__ void layout(const gp::Seg& s, int tid, unsigned (&voffA)[2], unsigned (&voffB)[2], long& hsA, long& hsB) const { gp::set_layout<AROWPERM>(LDA, LDB, gp::BT_STD, tid, voffA, voffB, hsA, hsB); }
};
template <int NTSEG, int LDA, int LDB, int PMASK, int NMASK> struct SchedHot {
    static constexpr bool LAYOUT_CHANGES = false; static constexpr int FIXED_NT = NTSEG;
    gp::TileOrder T; const char* A; const char* B;
    __device__ __forceinline__ bool next(int i, gp::Seg& s) const {
        int pm, pn; if (!T.tile(i, pm, pn)) return false;
        s.A = A + ((size_t)(pm & PMASK) * 256 * LDA) * 2; s.B = B + ((size_t)(pn & NMASK) * 256 * LDB) * 2;
        s.nt = NTSEG; s.flags = gp::F_FIRST | gp::F_LAST; s.u0 = pm; s.u1 = pn; return true;
    }
    __device__ __forceinline__ void layout(const gp::Seg& s, int tid, unsigned (&voffA)[2], unsigned (&voffB)[2], long& hsA, long& hsB) const { gp::set_layout(LDA, LDB, gp::BT_STD, tid, voffA, voffB, hsA, hsB); }
};
template <int NTSEG, int LDA, int LDB> struct SchedQuarter {
    static constexpr bool LAYOUT_CHANGES = false; static constexpr int FIXED_NT = NTSEG;
    int c; const char* A; const char* B;
    __device__ __forceinline__ bool next(int i, gp::Seg& s) const {
        if (i >= 4) return false;
        const int x = c & 7, w = c >> 3, pm = 16 * i + 2 * x + (w >> 4), pn = w & 15;
        s.A = A + ((size_t)pm * 256 * LDA) * 2; s.B = B + ((size_t)pn * 256 * LDB) * 2;
        s.nt = NTSEG; s.flags = gp::F_FIRST | gp::F_LAST; s.u0 = pm; s.u1 = pn; return true;
    }
    __device__ __forceinline__ void layout(const gp::Seg& s, int tid, unsigned (&voffA)[2], unsigned (&voffB)[2], long& hsA, long& hsB) const { gp::set_layout(LDA, LDB, gp::BT_STD, tid, voffA, voffB, hsA, hsB); }
};
struct SchedP2 {
    static constexpr bool LAYOUT_CHANGES = false; static constexpr int FIXED_NT = 0;
    int v; unsigned char* ws;
    __device__ __forceinline__ bool next(int i, gp::Seg& s) const {
        if (i > 0) return false;
        s.flags = gp::F_FIRST | gp::F_LAST;
        if (v < 128) { s.A = (const char*)(ws + WS_UG) + (size_t)v * 256 * UROW * 2; s.B = (const char*)(ws + WS_EG) + (size_t)v * 128 * 1024 * 2;
            s.nt = 16; s.u0 = v; s.u1 = 0; return true; }
        const int j = v - 128; s.nt = 64;
        if (j < 64) { const int pm = j >> 4, pn = j & 15; s.A = (const char*)(ws + WS_HM) + (size_t)pm * 256 * D * 2; s.B = (const char*)(ws + WS_WK) + (size_t)pn * 256 * D * 2; s.u0 = pm; s.u1 = pn; s.flags |= 1 << 8; return true; }
        const int jj = j - 64, pm = jj >> 4, pn = jj & 15; s.A = (const char*)(ws + WS_HM) + (size_t)pm * 256 * D * 2; s.B = (const char*)(ws + WS_WV) + (size_t)pn * 256 * D * 2; s.u0 = pm; s.u1 = pn; s.flags |= 2 << 8; return true;
    }
    __device__ __forceinline__ void layout(const gp::Seg& s, int tid, unsigned (&voffA)[2], unsigned (&voffB)[2], long& hsA, long& hsB) const { if (v < 128) gp::set_layout(UROW, 1024, gp::BT_ALIAS, tid, voffA, voffB, hsA, hsB); else gp::set_layout(D, D, gp::BT_STD, tid, voffA, voffB, hsA, hsB); }
};
struct SchedY {
    static constexpr bool LAYOUT_CHANGES = true; static constexpr int FIXED_NT = 0;
    int v, G; unsigned char* ws;
    __device__ __forceinline__ bool next(int i, gp::Seg& s) const {
        const int ui = i >> 1, sg = i & 1, j = ui * G + v; if (j >= NG * 4) return false;
        const int g = j >> 2, pn = (ui & 1) ? 3 - (j & 3) : (j & 3);
        s.u0 = g; s.u1 = pn;
        if (sg == 0) { s.A = (const char*)(ws + WS_UG) + (size_t)g * 256 * UROW * 2; s.B = (const char*)(ws + WS_LT) + (size_t)g * 16 * LROW * 2 + (63 - 16 * pn - 7 - 8 * 0) * 32;
            s.nt = 4 * (pn + 1); s.flags = gp::F_FIRST; }
        else { s.A = (const char*)(ws + WS_UG) + (size_t)g * 256 * UROW * 2 + 2048; s.B = (const char*)(ws + WS_FG) + ((size_t)g * 1024 + pn * 256) * 128 * 2;
            s.nt = 2; s.flags = gp::F_LAST; }
        return true;
    }
    __device__ __forceinline__ void layout(const gp::Seg& s, int tid, unsigned (&voffA)[2], unsigned (&voffB)[2], long& hsA, long& hsB) const { if (s.flags & gp::F_FIRST) gp::set_layout(UROW, 0, gp::BT_TOEP, tid, voffA, voffB, hsA, hsB); else gp::set_layout(UROW, 128, gp::BT_STD, tid, voffA, voffB, hsA, hsB); }
};
struct SchedAT {
    static constexpr bool LAYOUT_CHANGES = false; static constexpr int FIXED_NT = 8;
    int v; unsigned char* ws;
    __device__ __forceinline__ bool next(int i, gp::Seg& s) const {
        if (i > 1 || v >= 256) return false;
        const int b = v >> 6, h = (v >> 4) & 3, t = v & 15;
        s.nt = 8; s.flags = gp::F_FIRST | gp::F_LAST | (i << 8);
        if (i == 0) { s.A = (const char*)(ws + WS_KB) + (((size_t)b * NMEM) * D + h * HD); s.B = (const char*)(ws + WS_WQ) + (((size_t)t * 256) * D + h * HD); s.u0 = b * 1024 + h * 256; s.u1 = t * 256; }
        else { s.A = (const char*)(ws + WS_WO) + (((size_t)t * 256) * D + h * HD); s.B = (const char*)(ws + WS_VB) + (((size_t)b * NMEM) * D + h * HD); s.u0 = b * D + t * 256; s.u1 = h * 256; }
        return true;
    }
    __device__ __forceinline__ void layout(const gp::Seg& s, int tid, unsigned (&voffA)[2], unsigned (&voffB)[2], long& hsA, long& hsB) const { gp::set_layout(D / 2, D / 2, gp::BT_STD, tid, voffA, voffB, hsA, hsB); }
};
struct SchedS {
    static constexpr bool LAYOUT_CHANGES = false; static constexpr int FIXED_NT = 32;
    int v; unsigned char* ws;
    __device__ __forceinline__ bool next(int i, gp::Seg& s) const {
        if (i > 0 || v >= 256) return false;
        const int b = v >> 6, qt = (v >> 2) & 15, h = v & 3;
        s.A = (const char*)(ws + WS_X8) + (((size_t)b * SEQ + qt * 256) * D); s.B = (const char*)(ws + WS_WKB) + (((size_t)b * 1024 + h * 256) * D);
        s.nt = 32; s.flags = gp::F_FIRST | gp::F_LAST; s.u0 = b * NH + h; s.u1 = qt; return true;
    }
    __device__ __forceinline__ void layout(const gp::Seg& s, int tid, unsigned (&voffA)[2], unsigned (&voffB)[2], long& hsA, long& hsB) const { gp::set_layout(D / 2, D / 2, gp::BT_STD, tid, voffA, voffB, hsA, hsB); }
};
struct SchedAO {
    static constexpr bool LAYOUT_CHANGES = false; static constexpr int FIXED_NT = 8;
    gp::TileOrder T; unsigned char* ws;
    __device__ __forceinline__ bool next(int i, gp::Seg& s) const {
        int pm, pn; if (!T.tile(i, pm, pn)) return false;
        s.A = (const char*)(ws + WS_P) + ((size_t)pm * 256 * 1024); s.B = (const char*)(ws + WS_VWT) + (((size_t)(pm >> 4) * D + pn * 256) * 1024);
        s.nt = 8; s.flags = gp::F_FIRST | gp::F_LAST; s.u0 = pm; s.u1 = pn; return true;
    }
    __device__ __forceinline__ void layout(const gp::Seg& s, int tid, unsigned (&voffA)[2], unsigned (&voffB)[2], long& hsA, long& hsB) const { gp::set_layout(512, 512, gp::BT_STD, tid, voffA, voffB, hsA, hsB); }
};

#define EPI_ROW(ai, m) (128 * (ai) + 64 * wr + 16 * (m) + fr)
#define EPI_COL(bj) (128 * (bj) + 32 * wc + 8 * fq)
__device__ __forceinline__ u32x4 pack8(const f32x4& a, const f32x4& b) { u32x4 w; w.x = cvt_pk_bf16(a[0], a[1]); w.y = cvt_pk_bf16(a[2], a[3]); w.z = cvt_pk_bf16(b[0], b[1]); w.w = cvt_pk_bf16(b[2], b[3]); return w; }
__device__ __forceinline__ void unpack8(const u32x4& w, f32x4& a, f32x4& b) { a = (f32x4){bflo(w.x), bfhi(w.x), bflo(w.y), bfhi(w.y)}; b = (f32x4){bflo(w.z), bfhi(w.z), bflo(w.w), bfhi(w.w)}; }
__device__ __forceinline__ float sumsq8(const f32x4& a, const f32x4& b) { return (a[0] * a[0] + a[1] * a[1]) + (a[2] * a[2] + a[3] * a[3]) + (b[0] * b[0] + b[1] * b[1]) + (b[2] * b[2] + b[3] * b[3]); }
typedef f32x4 AccT[2][2][4][2];
__device__ __forceinline__ float fp8_clamp(float v) { return __builtin_amdgcn_fmed3f(v, -448.f, 448.f); }
__device__ __forceinline__ u32x2 pack8_fp8(const f32x4& a, const f32x4& b) { int w0 = __builtin_amdgcn_cvt_pk_fp8_f32(fp8_clamp(a[0]), fp8_clamp(a[1]), 0, false); w0 = __builtin_amdgcn_cvt_pk_fp8_f32(fp8_clamp(a[2]), fp8_clamp(a[3]), w0, true);
    int w1 = __builtin_amdgcn_cvt_pk_fp8_f32(fp8_clamp(b[0]), fp8_clamp(b[1]), 0, false); w1 = __builtin_amdgcn_cvt_pk_fp8_f32(fp8_clamp(b[2]), fp8_clamp(b[3]), w1, true); u32x2 r; r.x = (unsigned)w0; r.y = (unsigned)w1; return r; }
__device__ __forceinline__ void stg8(void* base, unsigned off, const u32x2& v) { *(u32x2*)((char*)base + off) = v; }
__device__ __forceinline__ float trunc16(float v) { return __uint_as_float(__float_as_uint(v) & 0xFFFF0000u); }
__device__ __forceinline__ unsigned q8(float v) { return (unsigned)(int)__builtin_rintf(__builtin_amdgcn_fmed3f(v, -127.f, 127.f)) & 255u; }
__device__ __forceinline__ u32x2 pack8_i8(const f32x4& a, const f32x4& b) { u32x2 r; r.x = q8(a[0]) | (q8(a[1]) << 8) | (q8(a[2]) << 16) | (q8(a[3]) << 24); r.y = q8(b[0]) | (q8(b[1]) << 8) | (q8(b[2]) << 16) | (q8(b[3]) << 24); return r; }
#ifndef MK_GLU_FP8
#define MK_GLU_FP8 1
#endif
constexpr bool GLU_FP8 = MK_GLU_FP8 != 0;
constexpr float S_X8 = 4.f, S_WKB8 = 32.f, S_P8 = 256.f, S_VWT8 = 32.f, S_Z8 = 4.f, S_GLU8 = 1024.f, S_KV8 = 16.f, S_WQ8 = 2048.f, S_WO8 = 2048.f;
__device__ __forceinline__ u32x4 ldg16(const void* base, unsigned off) { return *(const u32x4*)((const char*)base + off); }
__device__ __forceinline__ f32x4 ldg16f(const void* base, unsigned off) { return *(const f32x4*)((const char*)base + off); }
__device__ __forceinline__ void stg16(void* base, unsigned off, const u32x4& v) { *(u32x4*)((char*)base + off) = v; }
__device__ __forceinline__ void stg16f(void* base, unsigned off, const f32x4& v) { *(f32x4*)((char*)base + off) = v; }

struct EpiProj {
    static constexpr bool AFTER_DRAIN = false, HAS_MID = false;
    bf16* ug; bf16* pc;
    __device__ __forceinline__ void mid(AccT&, const gp::Seg&, int, int, int, int) const {}
    __device__ __forceinline__ void operator()(const AccT& acc, const gp::Seg& u, int wr, int wc, int fr, int fq) const {
        const int pm = u.u0, pn = u.u1;
        if (pn < 8) {
            const int b = pm >> 4, ch0 = (pm & 15) * 4;
#pragma unroll
            for (int ai = 0; ai < 2; ++ai)
#pragma unroll
                for (int m = 0; m < 4; ++m) { const int ch = ch0 + 2 * ai + wr, s = 16 * m + fr;
#pragma unroll
                    for (int bj = 0; bj < 2; ++bj) { const int c = 256 * pn + EPI_COL(bj), g = c >> 4, hi = c & 15;
                        stg16(ug, (unsigned)(((g * 256 + b * 64 + ch) * UROW + s * 16 + hi) * 2), pack8(acc[ai][bj][m][0], acc[ai][bj][m][1])); } }
        } else if (pn < 16) {
#pragma unroll
            for (int ai = 0; ai < 2; ++ai)
#pragma unroll
                for (int m = 0; m < 4; ++m) { const unsigned ro = (unsigned)(((256 * pm + EPI_ROW(ai, m)) * CW3 + 256 * (pn - 8)) * 2);
#pragma unroll
                    for (int bj = 0; bj < 2; ++bj) stg16(pc, ro + EPI_COL(bj) * 2, pack8(acc[ai][bj][m][0], acc[ai][bj][m][1])); }
        } else {
#pragma unroll
            for (int ai = 0; ai < 2; ++ai)
#pragma unroll
                for (int m = 0; m < 4; ++m) { const unsigned ro = (unsigned)(((256 * pm + EPI_ROW(ai, m)) * CW3 + CONVW + 128 * (pn - 16)) * 2);
                    stg16(pc, ro + EPI_COL(0) * 2, pack8(acc[ai][0][m][0] * acc[ai][1][m][0], acc[ai][0][m][1] * acc[ai][1][m][1])); }
        }
    }
};
struct EpiP2 {
    static constexpr bool AFTER_DRAIN = false, HAS_MID = false;
    float* sloc; bf16* kb; bf16* vt;
    __device__ __forceinline__ void mid(AccT&, const gp::Seg&, int, int, int, int) const {}
    __device__ __forceinline__ void operator()(const AccT& acc, const gp::Seg& u, int wr, int wc, int fr, int fq) const {
        const int kind = u.flags >> 8;
        if (kind == 0) {
#pragma unroll
            for (int ai = 0; ai < 2; ++ai)
#pragma unroll
                for (int m = 0; m < 4; ++m) { const unsigned ro = (unsigned)(((u.u0 * 256 + EPI_ROW(ai, m)) * 128 + EPI_COL(0)) * 4);
                    stg16f(sloc, ro, acc[ai][0][m][0]); stg16f(sloc, ro + 16, acc[ai][0][m][1]); }
        } else {
            bf16* base = (kind == 1) ? kb : vt; const int ldc = D;
#pragma unroll
            for (int ai = 0; ai < 2; ++ai)
#pragma unroll
                for (int m = 0; m < 4; ++m) { const unsigned ro = (unsigned)((256 * u.u0 + EPI_ROW(ai, m)) * ldc + 256 * u.u1);
#pragma unroll
                    for (int bj = 0; bj < 2; ++bj) stg8(base, ro + EPI_COL(bj), pack8_fp8(acc[ai][bj][m][0] * S_KV8, acc[ai][bj][m][1] * S_KV8)); }
        }
    }
};
struct EpiY {
    static constexpr bool AFTER_DRAIN = false, HAS_MID = false;
    const bf16* ug; const float* dd; bf16* z; unsigned char* z8;
    __device__ __forceinline__ void mid(AccT&, const gp::Seg&, int, int, int, int) const {}
    __device__ __forceinline__ void operator()(const AccT& acc, const gp::Seg& u, int wr, int wc, int fr, int fq) const {
        const int g = u.u0, pn = u.u1;
#pragma unroll
        for (int bj = 0; bj < 2; ++bj) { const int c = 256 * pn + EPI_COL(bj), t = c >> 4, ho = c & 15;
            const f32x4 d0 = *(const f32x4*)(dd + g * 16 + ho), d1 = *(const f32x4*)(dd + g * 16 + ho + 4);
#pragma unroll
            for (int ai = 0; ai < 2; ++ai)
#pragma unroll
                for (int m = 0; m < 4; ++m) { const int row = EPI_ROW(ai, m);
                    const u32x4 uw = ldg16(ug, (unsigned)(((g * 256 + row) * UROW + c) * 2)); f32x4 u0, u1; unpack8(uw, u0, u1);
                    f32x4 y0 = acc[ai][bj][m][0] + d0 * u0, y1 = acc[ai][bj][m][1] + d1 * u1;
#pragma unroll
                    for (int e = 0; e < 4; ++e) { y0[e] = gelu_tanh(y0[e]); y1[e] = gelu_tanh(y1[e]); }
                    const int tok = (row >> 6) * SEQ + (row & 63) * TCH + t;
                    stg16(z, (unsigned)((tok * SSMW + g * 16 + ho) * 2), pack8(y0, y1));
                    if constexpr (GLU_FP8) stg8(z8, (unsigned)(tok * SSMW + g * 16 + ho), pack8_fp8(y0 * S_Z8, y1 * S_Z8)); } }
    }
};
struct EpiGlu {
    static constexpr bool AFTER_DRAIN = false, HAS_MID = false;
    const bf16* z; const float* gb; bf16* mixed; float* rowss;
    __device__ __forceinline__ void mid(AccT&, const gp::Seg&, int, int, int, int) const {}
    __device__ __forceinline__ void operator()(const AccT& acc, const gp::Seg& u, int wr, int wc, int fr, int fq) const {
        const int pm = u.u0, pn = u.u1;
        f32x4 b0[2], b1[2];
#pragma unroll
        for (int bj = 0; bj < 2; ++bj) { const int c = 256 * pn + EPI_COL(bj); b0[bj] = *(const f32x4*)(gb + c); b1[bj] = *(const f32x4*)(gb + c + 4); }
#pragma unroll
        for (int ai = 0; ai < 2; ++ai)
#pragma unroll
            for (int m = 0; m < 4; ++m) { const int row = 256 * pm + EPI_ROW(ai, m); float ss = 0.f;
#pragma unroll
                for (int bj = 0; bj < 2; ++bj) { const int c = 256 * pn + EPI_COL(bj);
                    const u32x4 zw = ldg16(z, (unsigned)((row * SSMW + c) * 2)); f32x4 z0, z1; unpack8(zw, z0, z1);
                    f32x4 y0, y1;
#pragma unroll
                    for (int e = 0; e < 4; ++e) { y0[e] = z0[e] * fast_sigmoid(acc[ai][bj][m][0][e] * (GLU_FP8 ? 1.f / (S_Z8 * S_GLU8) : 1.f) + b0[bj][e]); y1[e] = z1[e] * fast_sigmoid(acc[ai][bj][m][1][e] * (GLU_FP8 ? 1.f / (S_Z8 * S_GLU8) : 1.f) + b1[bj][e]); }
                    ss += sumsq8(y0, y1);
                    stg16(mixed, (unsigned)((row * D + c) * 2), pack8(y0, y1)); }
                ss += __shfl_xor(ss, 16); ss += __shfl_xor(ss, 32);
                if (fq == 0) unsafeAtomicAdd(rowss + row, ss); }
    }
};
template <bool BASE_F32, bool HAS_MID_, bool WRITE_I8 = false> struct EpiRes {
    static constexpr bool AFTER_DRAIN = false, HAS_MID = HAS_MID_;
    const float* base; bf16* xb; float* rowss; const float* rss_mid; unsigned char* x8; unsigned char* a8; const float* rss_q;
    static constexpr float accscale = WRITE_I8 ? 1.f / (S_P8 * S_VWT8) : 1.f;
    __device__ __forceinline__ void mid(AccT& acc, const gp::Seg& u, int wr, int wc, int fr, int fq) const {
        const bool on = (u.flags & gp::F_MID) != 0;
#pragma unroll
        for (int ai = 0; ai < 2; ++ai)
#pragma unroll
            for (int m = 0; m < 4; ++m) { const int row = 256 * u.u0 + EPI_ROW(ai, m);
                const float r = on ? rsqrtf(__hip_atomic_load((float*)rss_mid + row, RLX_AGENT) * (1.f / SSMW) + EPS) : 1.f;
#pragma unroll
                for (int bj = 0; bj < 2; ++bj) { acc[ai][bj][m][0] = acc[ai][bj][m][0] * r; acc[ai][bj][m][1] = acc[ai][bj][m][1] * r; } }
    }
    __device__ __forceinline__ void operator()(const AccT& acc, const gp::Seg& u, int wr, int wc, int fr, int fq) const {
        const int pm = u.u0, pn = u.u1;
        if constexpr (BASE_F32) {
            f32x4 gi[2][2];
#pragma unroll
            for (int bj = 0; bj < 2; ++bj)
#pragma unroll
                for (int n = 0; n < 2; ++n) { const f32x4 g = *(const f32x4*)(base + 256 * pn + EPI_COL(bj) + 4 * n); gi[bj][n] = (f32x4){1.f / g[0], 1.f / g[1], 1.f / g[2], 1.f / g[3]}; }
#pragma unroll
            for (int ai = 0; ai < 2; ++ai) {
                u32x4 bw[4][2];
#pragma unroll
                for (int m = 0; m < 4; ++m)
#pragma unroll
                    for (int bj = 0; bj < 2; ++bj) bw[m][bj] = ldg16(xb, (unsigned)((256 * pm + EPI_ROW(ai, m)) * D + 256 * pn + EPI_COL(bj)) * 2u);
#pragma unroll
                for (int m = 0; m < 4; ++m) { const int row = 256 * pm + EPI_ROW(ai, m); float ss = 0.f; const float xr = rss_q[row];
#pragma unroll
                    for (int bj = 0; bj < 2; ++bj) { const unsigned off = (unsigned)(row * D + 256 * pn + EPI_COL(bj)); f32x4 b0, b1; unpack8(bw[m][bj], b0, b1);
                        const f32x4 x0 = b0 * (gi[bj][0] * xr) + acc[ai][bj][m][0], x1 = b1 * (gi[bj][1] * xr) + acc[ai][bj][m][1];
                        ss += sumsq8(x0, x1);
                        stg16(xb, off * 2, pack8(x0, x1)); stg8(x8, off, pack8_fp8(x0 * S_X8, x1 * S_X8)); }
                    ss += __shfl_xor(ss, 16); ss += __shfl_xor(ss, 32);
                    if (fq == 0) unsafeAtomicAdd(rowss + row, ss); }
                asm volatile("" ::: "memory"); }
        } else {
            constexpr int NB = WRITE_I8 ? 2 : 1;
#pragma unroll
            for (int hb = 0; hb < NB; ++hb) {
                u32x4 bw[2][4][2];
#pragma unroll
                for (int ai = hb * (2 / NB) ; ai < (hb + 1) * (2 / NB); ++ai)
#pragma unroll
                    for (int m = 0; m < 4; ++m)
#pragma unroll
                        for (int bj = 0; bj < 2; ++bj) bw[ai][m][bj] = ldg16(xb, (unsigned)((256 * pm + EPI_ROW(ai, m)) * D + 256 * pn + EPI_COL(bj)) * 2u);
#pragma unroll
                for (int ai = hb * (2 / NB); ai < (hb + 1) * (2 / NB); ++ai)
#pragma unroll
                    for (int m = 0; m < 4; ++m) { const int row = 256 * pm + EPI_ROW(ai, m); float ss = 0.f; float qinv = 0.f;
                        if constexpr (WRITE_I8) qinv = (127.f / QCLIP) * rsqrtf(trunc16(__hip_atomic_load((float*)rss_q + row, RLX_AGENT)) * (1.f / D) + EPS);
#pragma unroll
                        for (int bj = 0; bj < 2; ++bj) { const unsigned off = (unsigned)(row * D + 256 * pn + EPI_COL(bj)); f32x4 b0, b1; unpack8(bw[ai][m][bj], b0, b1);
                            const f32x4 x0 = b0 + acc[ai][bj][m][0] * accscale, x1 = b1 + acc[ai][bj][m][1] * accscale;
                            ss += sumsq8(x0, x1);
                            stg16(xb, off * 2, pack8(x0, x1));
                            if constexpr (WRITE_I8) stg8(a8, off, pack8_i8(x0 * qinv, x1 * qinv)); }
                        ss += __shfl_xor(ss, 16); ss += __shfl_xor(ss, 32);
                        if (fq == 0) unsafeAtomicAdd(rowss + row, ss); }
            }
        }
    }
};
struct EpiScaleBf {
    static constexpr bool AFTER_DRAIN = false, HAS_MID = false;
    const float* rowss; bf16* o; int ldc;
    __device__ __forceinline__ void mid(AccT&, const gp::Seg&, int, int, int, int) const {}
    __device__ __forceinline__ void operator()(const AccT& acc, const gp::Seg& u, int wr, int wc, int fr, int fq) const {
        const int pm = u.u0, pn = u.u1;
#pragma unroll
        for (int ai = 0; ai < 2; ++ai)
#pragma unroll
            for (int m = 0; m < 4; ++m) { const int row = 256 * pm + EPI_ROW(ai, m);
                const float r = rsqrtf(__hip_atomic_load((float*)rowss + row, RLX_AGENT) * (1.f / D) + EPS);
                const unsigned ro = (unsigned)(row * ldc + 256 * pn) * 2u;
#pragma unroll
                for (int bj = 0; bj < 2; ++bj) stg16(o, ro + EPI_COL(bj) * 2, pack8(acc[ai][bj][m][0] * r, acc[ai][bj][m][1] * r)); }
    }
};
template <int CTRL> __device__ __forceinline__ float dpp_f(float old, float src) { return __builtin_bit_cast(float, __builtin_amdgcn_update_dpp(__builtin_bit_cast(int, old), __builtin_bit_cast(int, src), CTRL, 0xf, 0xf, false)); }
template <int CTRL> __device__ __forceinline__ float dpp_rot(float src) { return __builtin_bit_cast(float, __builtin_amdgcn_mov_dpp(__builtin_bit_cast(int, src), CTRL, 0xf, 0xf, false)); }
#define FFN_TOK(ai, m) (128 * (ai) + 64 * wr + 4 * fr + (m))
struct EpiFfn {
    static constexpr bool AFTER_DRAIN = false, HAS_MID = false;
    const float* rowss; bf16* act; float* halo; const float* cw; const float* cb; LAS unsigned char* lds; const float* rss_q; const float* scb;
    __device__ __forceinline__ void mid(AccT&, const gp::Seg&, int, int, int, int) const {}
    __device__ __forceinline__ void operator()(AccT& acc, const gp::Seg& u, int wr, int wc, int fr, int fq) const {
        const int pm = u.u0, pn = u.u1, cl = 32 * wc + 8 * fq, ch = 128 * pn + cl;
        LAS float* EX = (LAS float*)(lds + EX_OFF);
        f32x4 sb[2][2];
#pragma unroll
        for (int bj = 0; bj < 2; ++bj)
#pragma unroll
            for (int n = 0; n < 2; ++n) sb[bj][n] = *(const f32x4*)(scb + 256 * pn + 128 * bj + cl + 4 * n);
#pragma unroll
        for (int ai = 0; ai < 2; ++ai)
#pragma unroll
            for (int m = 0; m < 4; ++m) { const int row = 256 * pm + FFN_TOK(ai, m);
                const float r = rsqrtf(__hip_atomic_load((float*)rowss + row, RLX_AGENT) * (1.f / D) + EPS) * (QCLIP / 127.f) * sqrtf(trunc16(__hip_atomic_load((float*)rss_q + row, RLX_AGENT)) * (1.f / D) + EPS);
#pragma unroll
                for (int bj = 0; bj < 2; ++bj)
#pragma unroll
                    for (int n = 0; n < 2; ++n) { const f32x4 sbr = sb[bj][n] * r; f32x4 cv;
#pragma unroll
                        for (int e = 0; e < 4; ++e) { const float f = acc[ai][bj][m][n][e]; cv[e] = (float)__float_as_int(f); }
                        acc[ai][bj][m][n] = cv * sbr; } }
#pragma unroll
        for (int ai = 0; ai < 2; ++ai) { const int blk = 2 * ai + wr;
            if (fr == 15) {
#pragma unroll
                for (int k = 0; k < 2; ++k) {
                    if (blk < 3) { LAS float* d = EX + (blk * 2 + k) * 128 + cl; *(LAS f32x4*)d = acc[ai][0][2 + k][0]; *(LAS f32x4*)(d + 4) = acc[ai][0][2 + k][1]; }
                    else { float* d = halo + ((size_t)(4 + k) * 64 + pm) * DFF + ch; *(f32x4*)d = acc[ai][0][2 + k][0]; *(f32x4*)(d + 4) = acc[ai][0][2 + k][1]; } } }
            if (blk == 0 && fr == 0) {
#pragma unroll
                for (int k = 0; k < 2; ++k) { float* d = halo + ((size_t)k * 64 + pm) * DFF + ch; *(f32x4*)d = acc[0][0][k][0]; *(f32x4*)(d + 4) = acc[0][0][k][1];
                    float* e = halo + ((size_t)(2 + k) * 64 + pm) * DFF + ch; *(f32x4*)e = acc[0][1][k][0]; *(f32x4*)(e + 4) = acc[0][1][k][1]; } } }
        LDS_WAIT(); __builtin_amdgcn_s_barrier(); asm volatile("" ::: "memory");
        f32x4 w0[2], w1[2], w2[2], bb[2];
#pragma unroll
        for (int n = 0; n < 2; ++n) { w0[n] = *(const f32x4*)(cw + ch + 4 * n); w1[n] = *(const f32x4*)(cw + DFF + ch + 4 * n); w2[n] = *(const f32x4*)(cw + 2 * DFF + ch + 4 * n); bb[n] = *(const f32x4*)(cb + ch + 4 * n); }
#pragma unroll
        for (int ai = 0; ai < 2; ++ai) { const int blk = 2 * ai + wr;
            f32x4 e2[2], e1[2];
            if (blk > 0) { const LAS float* sp = EX + ((blk - 1) * 2) * 128 + cl; e2[0] = *(const LAS f32x4*)sp; e2[1] = *(const LAS f32x4*)(sp + 4); e1[0] = *(const LAS f32x4*)(sp + 128); e1[1] = *(const LAS f32x4*)(sp + 132); }
            else { e2[0] = e2[1] = e1[0] = e1[1] = (f32x4){0.f, 0.f, 0.f, 0.f}; }
            f32x4 o[4][2];
#pragma unroll
            for (int n = 0; n < 2; ++n) {
                const f32x4 a0 = acc[ai][0][0][n], a1 = acc[ai][0][1][n], a2 = acc[ai][0][2][n], a3 = acc[ai][0][3][n];
                f32x4 p3, p2;
#pragma unroll
                for (int e = 0; e < 4; ++e) { p3[e] = dpp_f<0x111>(e1[n][e], a3[e]); p2[e] = dpp_f<0x111>(e2[n][e], a2[e]); }
                const f32x4 k0 = w0[n], k1 = w1[n], k2 = w2[n], kb = bb[n];
                const f32x4 s0 = k0 * p2 + (k1 * p3 + (k2 * a0 + kb));
                const f32x4 s1 = k0 * p3 + (k1 * a0 + (k2 * a1 + kb));
                const f32x4 s2 = k0 * a0 + (k1 * a1 + (k2 * a2 + kb));
                const f32x4 s3 = k0 * a1 + (k1 * a2 + (k2 * a3 + kb));
                o[0][n] = s0 * fast_sigmoid4(s0) * acc[ai][1][0][n]; o[1][n] = s1 * fast_sigmoid4(s1) * acc[ai][1][1][n];
                o[2][n] = s2 * fast_sigmoid4(s2) * acc[ai][1][2][n]; o[3][n] = s3 * fast_sigmoid4(s3) * acc[ai][1][3][n]; }
#pragma unroll
            for (int m = 0; m < 4; ++m) stg16(act, (unsigned)(((256 * pm + FFN_TOK(ai, m)) * DFF + ch) * 2), pack8(o[m][0], o[m][1])); }
    }
};
__device__ __forceinline__ void ffn_fixup_tile(const Frame& F, const Args& a, int pm) {
    if ((pm & 15) == 0) return;
    const float* cw = a.in[26]; const float* cb = a.in[27]; const float* halo = (const float*)(F.ws + WS_HALO); bf16* act = (bf16*)(F.ws + WS_ACT);
    for (int i = opaque_tid(); i < DFF / 4; i += NTHR) { const int c = i * 4;
        const f32x4 a0 = *(const f32x4*)(halo + ((size_t)0 * 64 + pm) * DFF + c), a1 = *(const f32x4*)(halo + ((size_t)1 * 64 + pm) * DFF + c);
        const f32x4 g0 = *(const f32x4*)(halo + ((size_t)2 * 64 + pm) * DFF + c), g1 = *(const f32x4*)(halo + ((size_t)3 * 64 + pm) * DFF + c);
        const f32x4 p2 = *(const f32x4*)(halo + ((size_t)4 * 64 + pm - 1) * DFF + c), p1 = *(const f32x4*)(halo + ((size_t)5 * 64 + pm - 1) * DFF + c);
        const f32x4 w0 = *(const f32x4*)(cw + c), w1 = *(const f32x4*)(cw + DFF + c), w2 = *(const f32x4*)(cw + 2 * DFF + c), bb = *(const f32x4*)(cb + c);
        f32x4 s0 = w0 * p2 + w1 * p1 + w2 * a0 + bb, s1 = w0 * p1 + w1 * a0 + w2 * a1 + bb;
#pragma unroll
        for (int e = 0; e < 4; ++e) { s0[e] = s0[e] * fast_sigmoid(s0[e]) * g0[e]; s1[e] = s1[e] * fast_sigmoid(s1[e]) * g1[e]; }
        u32x2 o0, o1; o0.x = cvt_pk_bf16(s0[0], s0[1]); o0.y = cvt_pk_bf16(s0[2], s0[3]); o1.x = cvt_pk_bf16(s1[0], s1[1]); o1.y = cvt_pk_bf16(s1[2], s1[3]);
        *(u32x2*)(act + (size_t)(256 * pm) * DFF + c) = o0; *(u32x2*)(act + (size_t)(256 * pm + 1) * DFF + c) = o1; }
}
struct EpiNull {
    static constexpr bool AFTER_DRAIN = false, HAS_MID = false;
    float* sink;
    __device__ __forceinline__ void mid(AccT&, const gp::Seg&, int, int, int, int) const {}
    __device__ __forceinline__ void operator()(const AccT& acc, const gp::Seg& u, int wr, int wc, int fr, int fq) const {
        f32x4 t = (f32x4){0.f, 0.f, 0.f, 0.f};
#pragma unroll
        for (int ai = 0; ai < 2; ++ai)
#pragma unroll
            for (int bj = 0; bj < 2; ++bj)
#pragma unroll
                for (int m = 0; m < 4; ++m) { t = t + acc[ai][bj][m][0]; t = t + acc[ai][bj][m][1]; }
        if ((t[0] + t[1]) + (t[2] + t[3]) == 12345.678f) sink[0] = 1.f; }
};
struct EpiAT {
    static constexpr bool AFTER_DRAIN = false, HAS_MID = false;
    bf16* wkb; bf16* vwt;
    __device__ __forceinline__ void mid(AccT&, const gp::Seg&, int, int, int, int) const {}
    __device__ __forceinline__ void operator()(const AccT& acc, const gp::Seg& u, int wr, int wc, int fr, int fq) const {
        const int kind = u.flags >> 8; bf16* o = kind ? vwt : wkb; const int ldc = kind ? 1024 : D; const float sc = kind ? S_VWT8 / (S_WO8 * S_KV8) : S_WKB8 / (S_KV8 * S_WQ8);
#pragma unroll
        for (int ai = 0; ai < 2; ++ai)
#pragma unroll
            for (int m = 0; m < 4; ++m) { const unsigned ro = (unsigned)((u.u0 + EPI_ROW(ai, m)) * ldc + u.u1);
#pragma unroll
                for (int bj = 0; bj < 2; ++bj) stg8(o, ro + EPI_COL(bj), pack8_fp8(acc[ai][bj][m][0] * sc, acc[ai][bj][m][1] * sc)); }
    }
};
struct EpiSoftmax {
    static constexpr bool AFTER_DRAIN = true, HAS_MID = false;
    bf16* P; const float* rowss;
    __device__ __forceinline__ void mid(AccT&, const gp::Seg&, int, int, int, int) const {}
    __device__ __forceinline__ void operator()(const AccT&, const gp::Seg&, int, int, int, int) const {}
    __device__ __forceinline__ void fused(AccT& acc, const gp::Seg& u, int wr, int wc, int fr, int fq, LAS unsigned char* lds, int wid, int lane) const {
        LAS float* Tm = (LAS float*)lds;
        LAS float* Ts = (LAS float*)(lds + 4096);
        const float sc = 0.03125f * 1.4426950408889634f;
        const int b = u.u0 >> 2, h = u.u0 & 3, qt = u.u1;
#pragma unroll
        for (int ai = 0; ai < 2; ++ai)
#pragma unroll
            for (int m = 0; m < 4; ++m) { float mx = -3.0e38f;
                const float r = rsqrtf(__hip_atomic_load((float*)rowss + b * SEQ + qt * 256 + EPI_ROW(ai, m), RLX_AGENT) * (1.f / D) + EPS) * (1.f / (S_X8 * S_WKB8));
#pragma unroll
                for (int bj = 0; bj < 2; ++bj) { acc[ai][bj][m][0] = acc[ai][bj][m][0] * r; acc[ai][bj][m][1] = acc[ai][bj][m][1] * r; }
#pragma unroll
                for (int bj = 0; bj < 2; ++bj)
#pragma unroll
                    for (int n = 0; n < 2; ++n)
#pragma unroll
                        for (int e = 0; e < 4; ++e) mx = fmaxf(mx, acc[ai][bj][m][n][e]);
                mx = fmaxf(mx, __shfl_xor(mx, 16)); mx = fmaxf(mx, __shfl_xor(mx, 32));
                if (fq == 0) Tm[EPI_ROW(ai, m) * 4 + wc] = mx; }
        LDS_WAIT(); __builtin_amdgcn_s_barrier(); asm volatile("" ::: "memory");
#pragma unroll
        for (int ai = 0; ai < 2; ++ai)
#pragma unroll
            for (int m = 0; m < 4; ++m) { const f32x4 t = *(const LAS f32x4*)(Tm + EPI_ROW(ai, m) * 4); const float mx = fmaxf(fmaxf(t[0], t[1]), fmaxf(t[2], t[3])); float s = 0.f;
#pragma unroll
                for (int bj = 0; bj < 2; ++bj)
#pragma unroll
                    for (int n = 0; n < 2; ++n)
#pragma unroll
                        for (int e = 0; e < 4; ++e) { const float p = __builtin_amdgcn_exp2f((acc[ai][bj][m][n][e] - mx) * sc); acc[ai][bj][m][n][e] = p; s += p; }
                s += __shfl_xor(s, 16); s += __shfl_xor(s, 32);
                if (fq == 0) Ts[EPI_ROW(ai, m) * 4 + wc] = s; }
        LDS_WAIT(); __builtin_amdgcn_s_barrier(); asm volatile("" ::: "memory");
#pragma unroll
        for (int ai = 0; ai < 2; ++ai)
#pragma unroll
            for (int m = 0; m < 4; ++m) { const f32x4 t = *(const LAS f32x4*)(Ts + EPI_ROW(ai, m) * 4); const float inv = S_P8 / ((t[0] + t[1]) + (t[2] + t[3]));
                const unsigned ro = (unsigned)((b * SEQ + qt * 256 + EPI_ROW(ai, m)) * 1024 + h * 256);
#pragma unroll
                for (int bj = 0; bj < 2; ++bj) stg8(P, ro + EPI_COL(bj), pack8_fp8(acc[ai][bj][m][0] * inv, acc[ai][bj][m][1] * inv)); }
        LDS_WAIT(); __builtin_amdgcn_s_barrier(); asm volatile("" ::: "memory");
    }
};

template <bool FFN_PERM = false, bool OUT_FP8 = false>
__device__ __forceinline__ void p0_transpose_item(const float* W, int K, int N, bf16* WT, const float* gk, LAS float* scr, int item, int lane, float sc8 = 1.f) {
    const int nblk = N / 64, kb = item / nblk, nb = item - kb * nblk, k0 = 64 * kb, n0 = 64 * nb;
    const int d0 = FFN_PERM ? ((n0 < 2 * SSMW) ? n0 : (n0 < 3 * SSMW) ? 2 * SSMW + ((n0 - 2 * SSMW) / 128) * 256 + (n0 % 128) : 2 * SSMW + ((n0 - 3 * SSMW) / 128) * 256 + 128 + (n0 % 128)) : n0;
    const int lk = lane >> 4, ln = (lane & 15) * 4;
    f32x4 v[16];
#pragma unroll
    for (int i = 0; i < 16; ++i) v[i] = *(const f32x4*)(W + (size_t)(k0 + 4 * i + lk) * N + n0 + ln);
    if (gk) {
#pragma unroll
        for (int i = 0; i < 16; ++i) v[i] = v[i] * gk[k0 + 4 * i + lk];
    }
#pragma unroll
    for (int i = 0; i < 16; ++i) { LAS float* d = scr + (4 * i + lk) * 65 + ln; d[0] = v[i].x; d[1] = v[i].y; d[2] = v[i].z; d[3] = v[i].w; }
    LDS_WAIT(); asm volatile("" ::: "memory");
    const int c = lane & 7;
#pragma unroll
    for (int j = 0; j < 8; ++j) { const int n = (lane >> 3) + 8 * j; const LAS float* s = scr + (8 * c) * 65 + n;
        if constexpr (OUT_FP8) { const f32x4 lo = (f32x4){s[0 * 65], s[1 * 65], s[2 * 65], s[3 * 65]} * sc8, hi = (f32x4){s[4 * 65], s[5 * 65], s[6 * 65], s[7 * 65]} * sc8;
            *(u32x2*)((unsigned char*)WT + (size_t)(d0 + n) * K + k0 + 8 * c) = pack8_fp8(lo, hi); }
        else { u32x4 o; o.x = pk2(s[0 * 65], s[1 * 65]); o.y = pk2(s[2 * 65], s[3 * 65]); o.z = pk2(s[4 * 65], s[5 * 65]); o.w = pk2(s[6 * 65], s[7 * 65]);
            *(u32x4*)(WT + (size_t)(d0 + n) * K + k0 + 8 * c) = o; } }
    LDS_WAIT(); asm volatile("" ::: "memory");
}
constexpr int WUP_KSUB = 8;
__device__ __forceinline__ void wup_colmax_item(const float* W, const float* gk, float* colss, int item, int lane) {
    constexpr int N = 2 * DFF, nblk = N / 64; const int kq = item / nblk, nb = item - kq * nblk, kb = WUP_KSUB * kq, k0 = 64 * kb, n0 = 64 * nb, lk = lane >> 4, ln = (lane & 15) * 4;
    f32x4 v[16];
#pragma unroll
    for (int i = 0; i < 16; ++i) v[i] = *(const f32x4*)(W + (size_t)(k0 + 4 * i + lk) * N + n0 + ln);
    f32x4 sq = (f32x4){0.f, 0.f, 0.f, 0.f};
#pragma unroll
    for (int i = 0; i < 16; ++i) { const f32x4 a = v[i] * gk[k0 + 4 * i + lk]; sq = sq + a * a; }
#pragma unroll
    for (int e = 0; e < 4; ++e) { float m = sq[e]; m += __shfl_xor(m, 16); m += __shfl_xor(m, 32); if (lane < 16) unsafeAtomicAdd(colss + n0 + ln + e, m); }
}
__device__ __forceinline__ void wup_quant_item(const float* W, const float* gk, const float* colss, unsigned char* W8, float* scb, LAS float* scr, int item, int lane) {
    constexpr int K = D, N = 2 * DFF, nblk = N / 64; const int kb = item / nblk, nb = item - kb * nblk, k0 = 64 * kb, n0 = 64 * nb;
    const int d0 = (n0 < DFF) ? (n0 / 128) * 256 + (n0 % 128) : ((n0 - DFF) / 128) * 256 + 128 + ((n0 - DFF) % 128);
    const int lk = lane >> 4, ln = (lane & 15) * 4;
    f32x4 v[16];
#pragma unroll
    for (int i = 0; i < 16; ++i) v[i] = *(const f32x4*)(W + (size_t)(k0 + 4 * i + lk) * N + n0 + ln);
#pragma unroll
    for (int i = 0; i < 16; ++i) v[i] = v[i] * gk[k0 + 4 * i + lk];
#pragma unroll
    for (int i = 0; i < 16; ++i) { LAS float* d = scr + (4 * i + lk) * 65 + ln; d[0] = v[i].x; d[1] = v[i].y; d[2] = v[i].z; d[3] = v[i].w; }
    LDS_WAIT(); asm volatile("" ::: "memory");
    if (kb == 0) scb[d0 + lane] = (QCLIPW / 127.f) * sqrtf(trunc16(__hip_atomic_load((float*)colss + n0 + lane, RLX_AGENT)) * ((float)WUP_KSUB / K) + 1e-30f);
    const int c = lane & 7;
#pragma unroll
    for (int j = 0; j < 8; ++j) { const int n = (lane >> 3) + 8 * j; const LAS float* s = scr + (8 * c) * 65 + n;
        const float inv = (127.f / QCLIPW) * rsqrtf(trunc16(__hip_atomic_load((float*)colss + n0 + n, RLX_AGENT)) * ((float)WUP_KSUB / K) + 1e-30f);
        const f32x4 lo = (f32x4){s[0 * 65], s[1 * 65], s[2 * 65], s[3 * 65]} * inv, hi = (f32x4){s[4 * 65], s[5 * 65], s[6 * 65], s[7 * 65]} * inv;
        *(u32x2*)(W8 + (size_t)(d0 + n) * K + k0 + 8 * c) = pack8_i8(lo, hi); }
    LDS_WAIT(); asm volatile("" ::: "memory");
}
__device__ __forceinline__ void rms_row_to_bf16(const float* xrow, const float* g, bf16* orow, int lane, float* rinv = nullptr) {
    const f32x4* xr = (const f32x4*)xrow + lane; const f32x4* gr = (const f32x4*)g + lane;
    f32x4 v[16]; float s = 0.f;
#pragma unroll
    for (int j = 0; j < 16; ++j) { v[j] = xr[64 * j]; s += (v[j].x * v[j].x + v[j].y * v[j].y) + (v[j].z * v[j].z + v[j].w * v[j].w); }
    const float ms = wave_sum(s) * (1.f / D) + EPS, r = rsqrtf(ms);
    if (rinv && lane == 0) *rinv = ms * r;
    u32x2* o8 = (u32x2*)orow + lane;
#pragma unroll
    for (int j = 0; j < 16; ++j) { const f32x4 gg = gr[64 * j]; u32x2 w; w.x = pk2(v[j].x * r * gg.x, v[j].y * r * gg.y); w.y = pk2(v[j].z * r * gg.z, v[j].w * r * gg.w); o8[64 * j] = w; }
}

__device__ __forceinline__ void cvt_row_to_bf16(const float* wrow, float gain, bf16* orow, int lane) {
    const f32x4* xr = (const f32x4*)wrow + 2 * lane; u32x2* o8 = (u32x2*)orow + lane; f32x4 v[16];
#pragma unroll
    for (int j = 0; j < 8; ++j) { v[2 * j] = xr[128 * j]; v[2 * j + 1] = xr[128 * j + 1]; }
#pragma unroll
    for (int j = 0; j < 8; ++j) o8[64 * j] = pack8_fp8(v[2 * j] * gain, v[2 * j + 1] * gain);
}
__device__ __forceinline__ void ssm_tables_group(const Frame& F, const Args& a, int g, int part) {
    LAS float* pwr = (LAS float*)(F.lds);
    LAS float* pwi = pwr + 65 * 64;
    LAS float* bbr = pwi + 65 * 64;
    LAS float* bbi = bbr + 64 * 16;
    LAS float* ccr = bbi + 64 * 16;
    LAS float* cci = ccr + 16 * 64;
    LAS float* kk = cci + 16 * 64;
    LAS float* cfl = kk + 64 * 16 * 16;
    const float* lam_re = a.in[4]; const float* lam_im = a.in[5]; const float* log_step = a.in[6];
    const float* b_re = a.in[7]; const float* b_im = a.in[8]; const float* c_re = a.in[9]; const float* c_im = a.in[10];
    unsigned char* ws = F.ws; const int tid = opaque_tid();
    const double step = exp((double)log_step[g]);
    if (tid < 64) { const int p = tid; const double lr = lam_re[g * NP + p], li = lam_im[g * NP + p]; const double mg = exp(lr * step), an = li * step, ar = mg * cos(an), ai = mg * sin(an);
        { const double den = lr * lr + li * li, nr = ar - 1.0, ni = ai; cfl[p] = (float)((nr * lr + ni * li) / den); cfl[64 + p] = (float)((ni * lr - nr * li) / den); }
        double pr = 1.0, pi = 0.0;
        for (int j = 0; j <= 64; ++j) { pwr[j * 64 + p] = (float)pr; pwi[j * 64 + p] = (float)pi; const double nr = pr * ar - pi * ai, ni = pr * ai + pi * ar; pr = nr; pi = ni; } }
    for (int i = tid; i < 16 * 64; i += NTHR) { ccr[i] = c_re[(size_t)g * GH * NP + i]; cci[i] = c_im[(size_t)g * GH * NP + i]; }
    __syncthreads();
    for (int i = tid; i < 64 * 16; i += NTHR) { const int p = i >> 4; const float cfr = cfl[p], cfi = cfl[64 + p], br = b_re[(size_t)g * NP * GH + i], bi = b_im[(size_t)g * NP * GH + i];
        bbr[i] = cfr * br - cfi * bi; bbi[i] = cfr * bi + cfi * br; }
    __syncthreads();
    if (part != 1) {
    if (tid < 64) { float* a64 = (float*)(ws + WS_A64) + ((size_t)g * NP + tid) * 2; a64[0] = pwr[64 * 64 + tid]; a64[1] = pwi[64 * 64 + tid]; }
    for (int i = tid; i < 64 * 16; i += NTHR) { const int j = i >> 4, ho = i & 15; float acc[16];
#pragma unroll
        for (int hi = 0; hi < 16; ++hi) acc[hi] = 0.f;
        for (int p = 0; p < 64; ++p) { const float cr = ccr[ho * 64 + p], ci = cci[ho * 64 + p], pr = pwr[j * 64 + p], pi = pwi[j * 64 + p]; const float tr = cr * pr - ci * pi, ti = cr * pi + ci * pr;
#pragma unroll
            for (int hi = 0; hi < 16; ++hi) acc[hi] += tr * bbr[p * 16 + hi] - ti * bbi[p * 16 + hi]; }
#pragma unroll
        for (int hi = 0; hi < 16; ++hi) kk[(j * 16 + ho) * 16 + hi] = acc[hi]; }
    __syncthreads();
    bf16* lt = (bf16*)(ws + WS_LT) + (size_t)g * 16 * LROW;
    for (int i = tid; i < 16 * 127 * 8; i += NTHR) { const int hp = i & 7, q = (i >> 3) % 127, ho = (i >> 3) / 127;
        unsigned w = 0u; if (q <= 63) { const LAS float* k2 = kk + ((63 - q) * 16 + ho) * 16 + 2 * hp; w = pk2(k2[0], k2[1]); }
        *(unsigned*)(lt + (size_t)ho * LROW + q * 16 + 2 * hp) = w; }
    }
    if (part != 0) {
    bf16* eg = (bf16*)(ws + WS_EG) + (size_t)g * 128 * 1024;
    for (int i = tid; i < 128 * 512; i += NTHR) { const int cp = i & 511, row = i >> 9, p = row >> 1, ri = row & 1, s = cp >> 3, hi = (cp & 7) * 2;
        const float pr = pwr[(63 - s) * 64 + p], pi = pwi[(63 - s) * 64 + p]; const float b0r = bbr[p * 16 + hi], b0i = bbi[p * 16 + hi], b1r = bbr[p * 16 + hi + 1], b1i = bbi[p * 16 + hi + 1];
        const float v0 = ri ? (pr * b0i + pi * b0r) : (pr * b0r - pi * b0i), v1 = ri ? (pr * b1i + pi * b1r) : (pr * b1r - pi * b1i);
        *(unsigned*)(eg + (size_t)row * 1024 + s * 16 + hi) = pk2(v0, v1); }
    bf16* fg = (bf16*)(ws + WS_FG) + (size_t)g * 1024 * 128;
    for (int i = tid; i < 1024 * 64; i += NTHR) { const int p = i & 63, row = i >> 6, t = row >> 4, ho = row & 15;
        const float cr = ccr[ho * 64 + p], ci = cci[ho * 64 + p], pr = pwr[(t + 1) * 64 + p], pi = pwi[(t + 1) * 64 + p];
        *(unsigned*)(fg + (size_t)row * 128 + 2 * p) = pk2(cr * pr - ci * pi, -(cr * pi + ci * pr)); }
    }
    __syncthreads();
}

__device__ __forceinline__ void conv_phase(const Frame& F, const Args& a) {
    LAS float* cw = (LAS float*)F.lds;
    const float* conv_w = a.in[14]; const int tid = opaque_tid();
    for (int i = tid; i < 3 * CONVW; i += NTHR) cw[i] = conv_w[i];
    __syncthreads();
    const bf16* pc = (const bf16*)(F.ws + WS_PC); bf16* mixed = (bf16*)(F.ws + WS_MIX);
    const int gw = F.vcu * NWAVES + F.wave, NGW = F.G * NWAVES, lane = tid & 63;
    for (int run = gw; run < M / 8; run += NGW) {
        const int r0 = run * 8; const bool hist = (r0 % SEQ) != 0;
        f32x4 h1[4][2], h2[4][2];
#pragma unroll
        for (int j = 0; j < 4; ++j) { const int c = 8 * lane + 512 * j;
            if (hist) { const bf16* p1 = pc + (size_t)(r0 - 1) * CW3, * p2 = pc + (size_t)(r0 - 2) * CW3;
                unpack8(*(const u32x4*)(p1 + CONVW + c), h1[j][0], h1[j][1]); unpack8(*(const u32x4*)(p2 + CONVW + c), h2[j][0], h2[j][1]); }
            else { h1[j][0] = h1[j][1] = h2[j][0] = h2[j][1] = (f32x4){0.f, 0.f, 0.f, 0.f}; } }
        for (int rr = 0; rr < 8; ++rr) { const bf16* pr = pc + (size_t)(r0 + rr) * CW3; f32x4 y[4][2]; float ss = 0.f;
#pragma unroll
            for (int j = 0; j < 4; ++j) { const int c = 8 * lane + 512 * j; f32x4 g0, g1, cv0, cv1;
                unpack8(*(const u32x4*)(pr + c), g0, g1); unpack8(*(const u32x4*)(pr + CONVW + c), cv0, cv1);
                const f32x4 w00 = *(const LAS f32x4*)(cw + c), w01 = *(const LAS f32x4*)(cw + c + 4), w10 = *(const LAS f32x4*)(cw + CONVW + c), w11 = *(const LAS f32x4*)(cw + CONVW + c + 4),
                            w20 = *(const LAS f32x4*)(cw + 2 * CONVW + c), w21 = *(const LAS f32x4*)(cw + 2 * CONVW + c + 4);
                y[j][0] = g0 * (w00 * h2[j][0] + w10 * h1[j][0] + w20 * cv0); y[j][1] = g1 * (w01 * h2[j][1] + w11 * h1[j][1] + w21 * cv1);
                h2[j][0] = h1[j][0]; h2[j][1] = h1[j][1]; h1[j][0] = cv0; h1[j][1] = cv1;
                ss += sumsq8(y[j][0], y[j][1]); }
            const float r = rsqrtf(wave_sum(ss) * (1.f / CONVW) + EPS);
#pragma unroll
            for (int j = 0; j < 4; ++j) { const int c = 8 * lane + 512 * j; *(u32x4*)(mixed + (size_t)(r0 + rr) * D + SSMW + c) = pack8(y[j][0] * r, y[j][1] * r); } }
    }
}

__device__ __forceinline__ void scan_group(const Frame& F, int g) {
    VM_WAIT(); __syncthreads();
    const int t = opaque_tid(); if (t >= BATCH * NP) return;
    const int p = t & 63, b = t >> 6;
    const float* a64 = (const float*)(F.ws + WS_A64) + ((size_t)g * NP + p) * 2; const float ar = a64[0], ai = a64[1];
    float* sl = (float*)(F.ws + WS_SLOC) + ((size_t)g * 256 + b * 64) * 128 + 2 * p;
    bf16* ug = (bf16*)(F.ws + WS_UG) + ((size_t)g * 256 + b * 64) * UROW + 1024 + 2 * p;
    float sr = 0.f, si = 0.f;
    for (int c0 = 0; c0 < NCH; c0 += 16) { float vr[16], vi[16];
#pragma unroll
        for (int k = 0; k < 16; ++k) { vr[k] = __hip_atomic_load(sl + (size_t)(c0 + k) * 128, RLX_AGENT); vi[k] = __hip_atomic_load(sl + (size_t)(c0 + k) * 128 + 1, RLX_AGENT); }
#pragma unroll
        for (int k = 0; k < 16; ++k) { *(unsigned*)(ug + (size_t)(c0 + k) * UROW) = pk2(sr, si);
            const float nr = ar * sr - ai * si + vr[k], ni = ar * si + ai * sr + vi[k]; sr = nr; si = ni; } }
}

#ifndef MK_PH_LO
#define MK_PH_LO 0
#endif
#ifndef MK_PH_HI
#define MK_PH_HI 99
#endif
__global__ void __launch_bounds__(NTHR, 2) mk_fwd(Args args) {
    extern __shared__ __attribute__((aligned(16))) unsigned char lds[];
    Frame F;
    F.lds = (LAS unsigned char*)lds; F.MISC = (volatile LAS unsigned*)(F.lds + MISC_OFF);
    F.wave = __builtin_amdgcn_readfirstlane((int)threadIdx.x >> 6);
    F.G = gridDim.x; { const int bx = blockIdx.x; F.vcu = (F.G % 8 == 0) ? (bx % 8) * (F.G / 8) + bx / 8 : bx; }
    F.ws = args.ws; F.out = args.out; F.ctl = (unsigned*)(args.ws + WS_CTL);
    for (int u = threadIdx.x; u < (LDS_BYTES - LDSCTL_OFF) / 4; u += NTHR) ((LAS unsigned*)(F.lds + LDSCTL_OFF))[u] = 0u;
    __syncthreads();
    XcdBarrier bar = xcd_barrier_post(F.ctl + CW_BAR, F.MISC + 8);
    unsigned char* ws = F.ws;
    float* rss_ssm = (float*)(ws + WS_CTL + CTL_ROWSS); float* rss1 = rss_ssm + M; float* rss2 = rss1 + M; float* rss3 = rss2 + M; float* rss_dummy = rss3 + M; (void)rss_dummy;
    bf16* xb = (bf16*)(ws + WS_XB);
    const int c = (int)blockIdx.x;
#ifndef MK_DUP
#define MK_DUP -1
#endif
#define RSS(k, p) (((k) == MK_DUP && _rep == 0) ? rss_dummy : (p))
#define PH(k) for (int _rep = 0; _rep < ((k) == MK_DUP ? 2 : 1); ++_rep) if ((k) >= MK_PH_LO && (k) < MK_PH_HI)

    PH(0) {
        if (F.G >= 2 * NG) { if (F.vcu < 2 * NG) ssm_tables_group(F, args, F.vcu >> 1, F.vcu & 1); }
        else if (F.vcu < NG) ssm_tables_group(F, args, F.vcu, -1);
        LAS float* scr = (LAS float*)(F.lds + F.wave * TP_TILE); const int lane0 = opaque_tid() & 63;
        const int gw = F.vcu * NWAVES + F.wave, NGW = F.G * NWAVES;
        constexpr int I_IN = (D / 64) * (PROJW / 64), I_GLU = (SSMW / 64) * (SSMW / 64), I_DD = (D / 64) * (D / 64), I_UP = (D / 64) * (2 * DFF / 64), I_DN = (DFF / 64) * (D / 64);
        constexpr int NITEMS = I_IN + 2 * I_DD;
        for (int it = gw; it < NITEMS; it += NGW) {
            int r = it;
            if (r < I_IN) { p0_transpose_item<true>(args.in[3], D, PROJW, (bf16*)(ws + WS_WIN), nullptr, scr, r, lane0); continue; } r -= I_IN;
            if (r < I_DD) { p0_transpose_item(args.in[21], D, D, (bf16*)(ws + WS_WK), nullptr, scr, r, lane0); continue; } r -= I_DD;
            p0_transpose_item(args.in[22], D, D, (bf16*)(ws + WS_WV), nullptr, scr, r, lane0);
        }
        for (int m = gw; m < M; m += NGW) rms_row_to_bf16(args.in[0] + (size_t)m * D, args.in[2], xb + (size_t)m * D, lane0, (float*)(ws + WS_CTL + CTL_XRMS) + m);
        for (int m = gw; m < D; m += NGW) cvt_row_to_bf16(args.in[20] + (size_t)m * D, args.in[18][m] * S_WQ8, (bf16*)(ws + WS_WQ + (size_t)m * D), lane0);
        for (int m = gw; m < MROWS; m += NGW) rms_row_to_bf16(args.in[1] + (size_t)m * D, args.in[19], (bf16*)(ws + WS_HM) + (size_t)m * D, lane0);
        xcd_barrier(bar);
    }
    PH(1) {
        SchedStd<D / 64, 1, D, D, 0> S; S.T.init(M / 256, PROJW / 256, F.G, c); S.A = (const char*)xb; S.B = (const char*)(ws + WS_WIN);
        EpiProj E{(bf16*)(ws + WS_UG), (bf16*)(ws + WS_PC)};
        constexpr int I_UP1 = (D / 64) * (2 * DFF / 64); const int lane1 = opaque_tid() & 63; const bool early1 = (F.vcu & 1) != 0;
        if (early1) for (int it = F.vcu * NWAVES + F.wave; it < I_UP1 / WUP_KSUB; it += F.G * NWAVES) wup_colmax_item(args.in[25], args.in[24], (float*)(ws + WS_CTL + CTL_COLMAX), it, lane1);
        gp::gemm_phase(F.lds, S, E);
        if (!early1) for (int it = F.vcu * NWAVES + F.wave; it < I_UP1 / WUP_KSUB; it += F.G * NWAVES) wup_colmax_item(args.in[25], args.in[24], (float*)(ws + WS_CTL + CTL_COLMAX), it, lane1);
        xcd_barrier(bar);
    }
    PH(2) {
        SchedP2 S{F.vcu, ws}; EpiP2 E{(float*)(ws + WS_SLOC), (bf16*)(ws + WS_KB), (bf16*)(ws + WS_VB)};
        gp::gemm_phase(F.lds, S, E);
        if (F.vcu < NG) scan_group(F, F.vcu);
        __syncthreads();
        conv_phase(F, args);
        if (F.vcu < NG) {
            __syncthreads();
            constexpr int I_GLU = (SSMW / 64) * (SSMW / 64), I_DD = (D / 64) * (D / 64);
            LAS float* scr = (LAS float*)(F.lds + F.wave * TP_TILE); const int lane0 = opaque_tid() & 63;
            for (int it = F.vcu * NWAVES + F.wave; it < I_GLU + 2 * I_DD; it += NG * NWAVES) {
                int r = it;
                if (r < I_GLU) { p0_transpose_item<false, GLU_FP8>(args.in[12], SSMW, SSMW, (bf16*)(ws + WS_GLU), nullptr, scr, r, lane0, S_GLU8); continue; } r -= I_GLU;
                if (r < I_DD) { const int kb = r / (D / 64); p0_transpose_item(args.in[17], D, D, (bf16*)(ws + WS_WOUT), (kb < 32) ? args.in[15] : args.in[16] - SSMW, scr, r, lane0); continue; } r -= I_DD;
                p0_transpose_item<false, true>(args.in[23], D, D, (bf16*)(ws + WS_WO), nullptr, scr, r, lane0, S_WO8);
            }
        }
        xcd_barrier(bar);
    }
    PH(4) {
        constexpr int I_UP4 = (D / 64) * (2 * DFF / 64); const bool early4 = (F.vcu & 1) != 0;
        if (early4) {
            LAS float* scr = (LAS float*)(F.lds + F.wave * TP_TILE); const int lane4 = opaque_tid() & 63;
            for (int it = F.vcu * NWAVES + F.wave; it < I_UP4; it += F.G * NWAVES) wup_quant_item(args.in[25], args.in[24], (const float*)(ws + WS_CTL + CTL_COLMAX), ws + WS_WUP, (float*)(ws + WS_SCB), scr, it, lane4);
            __syncthreads(); }
        { SchedAT S{F.vcu, ws}; EpiAT E{(bf16*)(ws + WS_WKB), (bf16*)(ws + WS_VWT)}; gp::gemm_phase<EpiAT, SchedAT, true, 0, true>(F.lds, S, E); }
        SchedY S{F.vcu, F.G, ws}; EpiY E{(const bf16*)(ws + WS_UG), args.in[11], (bf16*)(ws + WS_Z), ws + WS_Z8};
        gp::gemm_phase(F.lds, S, E);
        if (!early4) { VM_WAIT(); __syncthreads();
            LAS float* scr = (LAS float*)(F.lds + F.wave * TP_TILE); const int lane4 = opaque_tid() & 63;
            for (int it = F.vcu * NWAVES + F.wave; it < I_UP4; it += F.G * NWAVES) wup_quant_item(args.in[25], args.in[24], (const float*)(ws + WS_CTL + CTL_COLMAX), ws + WS_WUP, (float*)(ws + WS_SCB), scr, it, lane4); }
        xcd_barrier(bar);
    }
    PH(5) {
        EpiGlu E{(const bf16*)(ws + WS_Z), args.in[13], (bf16*)(ws + WS_MIX), RSS(5, rss_ssm)};
        if constexpr (GLU_FP8) { SchedStd<SSMW / 128, 1, SSMW / 2, SSMW / 2, 0> S; S.T.init(M / 256, SSMW / 256, F.G, c); S.A = (const char*)(ws + WS_Z8); S.B = (const char*)(ws + WS_GLU);
            gp::gemm_phase<EpiGlu, decltype(S), true, 0, true>(F.lds, S, E); }
        else { SchedStd<SSMW / 64, 1, SSMW, SSMW, 0> S; S.T.init(M / 256, SSMW / 256, F.G, c); S.A = (const char*)(ws + WS_Z); S.B = (const char*)(ws + WS_GLU);
            gp::gemm_phase(F.lds, S, E); }
        xcd_barrier(bar);
    }
    PH(6) {
        SchedStd<SSMW / 64, 2, D, D, gp::F_MID> S; S.T.init(M / 256, D / 256, F.G, c); S.A = (const char*)(ws + WS_MIX); S.B = (const char*)(ws + WS_WOUT);
        EpiRes<true, true> E{args.in[2], xb, RSS(6, rss1), rss_ssm, ws + WS_X8, nullptr, (const float*)(ws + WS_CTL + CTL_XRMS)};
        gp::gemm_phase(F.lds, S, E);
        xcd_barrier(bar);
    }
    PH(8) {
        SchedS S{F.vcu, ws}; EpiSoftmax E{(bf16*)(ws + WS_P), rss1};
        gp::gemm_phase<EpiSoftmax, SchedS, true, 0, true>(F.lds, S, E);
        xcd_barrier(bar);
    }
    PH(10) {
        SchedAO S; S.T.init(M / 256, D / 256, F.G, c); S.ws = ws;
        EpiRes<false, false, true> E{nullptr, xb, rss2, nullptr, nullptr, ws + WS_A8, rss1};
        gp::gemm_phase<EpiRes<false, false, true>, SchedAO, true, 0, true>(F.lds, S, E);
        xcd_barrier(bar);
    }
    PH(11) {
        SchedStd<D / 128, 1, D / 2, D / 2, 0, true> S; S.T.init(M / 256, 2 * DFF / 256, F.G, c); S.A = (const char*)(ws + WS_A8); S.B = (const char*)(ws + WS_WUP);
        EpiFfn E{rss2, (bf16*)(ws + WS_ACT), (float*)(ws + WS_HALO), args.in[26], args.in[27], F.lds, rss1, (const float*)(ws + WS_SCB)};
        gp::gemm_phase<EpiFfn, decltype(S), true, 0, false, true>(F.lds, S, E);
        {
            constexpr int I_DN = (DFF / 64) * (D / 64); const int half = F.G / 2, cc = c - half;
            if (cc >= 0) { __syncthreads(); LAS float* scr = (LAS float*)(F.lds + F.wave * TP_TILE); const int lane0 = opaque_tid() & 63;
                for (int it = cc * NWAVES + F.wave; it < I_DN; it += half * NWAVES) p0_transpose_item(args.in[28], DFF, D, (bf16*)(ws + WS_WDN), nullptr, scr, it, lane0); }
        }
        xcd_barrier(bar);
    }
    PH(13) {
        SchedStd<DFF / 64, 1, DFF, DFF, 0> S; S.T.init(M / 256, D / 256, F.G, c, 4);     S.A = (const char*)(ws + WS_ACT) + (DFF / 64 - 1) * 128; S.B = (const char*)(ws + WS_WDN) + (DFF / 64 - 1) * 128;
        { int pm0, pn0, pm1, pn1, i1 = 0; bool same = S.T.tile(0, pm0, pn0);
          while (S.T.tile(++i1, pm1, pn1)) same = same && (pm1 == pm0);
          if (S.T.tile(0, pm0, pn0)) { if (same) ffn_fixup_tile(F, args, pm0); else { int pmd = -1; for (int i2 = 0; S.T.tile(i2, pm1, pn1); ++i2) { if (pm1 != pmd) ffn_fixup_tile(F, args, pm1); pmd = pm1; } }     }
          VM_WAIT(); __syncthreads(); }
#if MK_DUP == 131
        { SchedQuarter<DFF / 64, DFF, DFF> S0{c, (const char*)(ws + WS_ACT), (const char*)(ws + WS_WDN)}; EpiNull E0{rss_dummy}; gp::gemm_phase(F.lds, S0, E0); xcd_barrier(bar); }
#endif
#if MK_DUP == 132
        { EpiNull E0{rss_dummy}; gp::gemm_phase(F.lds, S, E0); xcd_barrier(bar); }
#endif
        EpiRes<false, false> E{nullptr, xb, RSS(13, rss3), nullptr, nullptr, nullptr, nullptr};
        gp::gemm_phase<EpiRes<false, false>, decltype(S), true, 0, false, false, true>(F.lds, S, E);
        xcd_barrier(bar);
    }
    PH(14) {
        const int gw = F.vcu * NWAVES + F.wave, NGW = F.G * NWAVES, lane14 = opaque_tid() & 63; const float* gf = args.in[29];
        for (int m = gw; m < M; m += NGW) { const float r = rsqrtf(__hip_atomic_load(rss3 + m, RLX_AGENT) * (1.f / D) + EPS);
            const u32x4* xr = (const u32x4*)(xb + (size_t)m * D) + lane14; f32x4* orow = (f32x4*)(F.out + (size_t)m * D) + 2 * lane14;
            u32x4 v[8];
#pragma unroll
            for (int j = 0; j < 8; ++j) v[j] = xr[64 * j];
#pragma unroll
            for (int j = 0; j < 8; ++j) { f32x4 a, b; unpack8(v[j], a, b); const f32x4 g0 = *(const f32x4*)(gf + 512 * j + 8 * lane14), g1 = *(const f32x4*)(gf + 512 * j + 8 * lane14 + 4);
                orow[128 * j] = a * g0 * r; orow[128 * j + 1] = b * g1 * r; } }
    }
#undef PH
}

extern "C" void kernel_launch(void* const* d_in, const int* in_sizes, int n_in, void* d_out, int out_size, void* d_ws, size_t ws_size, hipStream_t stream) {
    static int grid = 0;
    if (grid == 0) {
        if (n_in != 30 || in_sizes[0] != M * D || out_size != M * D || ws_size < WS_END) { fprintf(stderr, "kernel_launch: unexpected shapes (n_in %d, out %d, ws %zu, need %zu); nothing launched\n", n_in, out_size, ws_size, (size_t)WS_END); grid = -1; return; }
        int dev = 0, cus = 0, per_cu = 0;
        if (hipGetDevice(&dev) != hipSuccess || hipDeviceGetAttribute(&cus, hipDeviceAttributeMultiprocessorCount, dev) != hipSuccess) { grid = -1; return; }
        if (hipFuncSetAttribute((const void*)mk_fwd, hipFuncAttributeMaxDynamicSharedMemorySize, LDS_BYTES) != hipSuccess) { fprintf(stderr, "kernel_launch: hipFuncSetAttribute failed\n"); grid = -1; return; }
        if (hipOccupancyMaxActiveBlocksPerMultiprocessor(&per_cu, (const void*)mk_fwd, NTHR, LDS_BYTES) != hipSuccess || per_cu < 1) { fprintf(stderr, "kernel_launch: occupancy query says %d\n", per_cu); }
        (void)hipGetLastError();
        grid = cus;
    }
    if (grid < 0) return;
    if (hipMemsetAsync((char*)d_ws + WS_CTL, 0, CTL_ZERO_BYTES, stream) != hipSuccess) return;
    Args a{};
    for (int i = 0; i < 30; ++i) a.in[i] = (const float*)d_in[i];
    a.out = (float*)d_out; a.ws = (unsigned char*)d_ws;
    hipLaunchKernelGGL(mk_fwd, dim3(grid), dim3(NTHR), LDS_BYTES, stream, a);
}
```
